# Optimizing an MI355X kernel written in HIP

```python
import jax, jax.numpy as jnp
from jax import lax
import numpy as np

D_MODEL = 1024
BATCH = 32
SEQ = 2048
DEPTH = 2

MEM_LEN = 256
BRANCH_WIDTH = D_MODEL // 2
N_BRANCH = 4

RWKV_HEAD_DIM = 64
RWKV_HEADS = BRANCH_WIDTH // RWKV_HEAD_DIM
RWKV_LORA = 64
RWKV_GN_EPS = 64e-5

MLA_NOPE = 64
MLA_ROPE = 32
MLA_V = 64
MLA_HEADS = BRANCH_WIDTH // MLA_V
MLA_Q_LORA = 3 * D_MODEL // 8
MLA_KV_LORA = D_MODEL // 4
ROPE_THETA = 10000.0
Q_BLOCK = 128

CONV_KERNEL = 31

XATTN_HEADS = 4
XATTN_HEAD_DIM = BRANCH_WIDTH // XATTN_HEADS

DEEPNORM_ALPHA = (2.0 * DEPTH) ** 0.25
DEEPNORM_BETA = (8.0 * DEPTH) ** -0.25
LN_EPS = 1e-5
RMS_EPS = 1e-6
MASK_VALUE = -1e30

RWKV_SHIFT_COLS = 3 * BRANCH_WIDTH + 2 * RWKV_LORA
SPLIT_SIZES = (
    RWKV_SHIFT_COLS, BRANCH_WIDTH,
    MLA_Q_LORA, MLA_KV_LORA, MLA_ROPE, BRANCH_WIDTH,
    2 * BRANCH_WIDTH, BRANCH_WIDTH,
    BRANCH_WIDTH, BRANCH_WIDTH,
    N_BRANCH * D_MODEL,
)
SPLIT_POINTS = tuple(int(s) for s in np.cumsum(SPLIT_SIZES)[:-1])
IN_COLS = int(sum(SPLIT_SIZES))

kernel_name = "hybrid_rwkv7_mla_conformer_xattn_deepnorm"


def _layer_norm(x, g, b):
    xf = x.astype(jnp.float32)
    mu = jnp.mean(xf, -1, keepdims=True)
    var = jnp.mean(jnp.square(xf - mu), -1, keepdims=True)
    return ((xf - mu) * lax.rsqrt(var + LN_EPS)).astype(x.dtype) * g + b


def _rms_norm(x, g):
    xf = x.astype(jnp.float32)
    y = xf * lax.rsqrt(jnp.mean(jnp.square(xf), -1, keepdims=True) + RMS_EPS)
    return y.astype(x.dtype) * g


def _rope(x, cos, sin):
    half = x.shape[-1] // 2
    x1, x2 = x[..., :half], x[..., half:]
    return jnp.concatenate([x1 * cos - x2 * sin, x1 * sin + x2 * cos], axis=-1)


def _rwkv7_branch(p, gate, mu, w0, w2, a0, a2, k_k, k_a, r_k, lnx_g, lnx_b):
    B, S, _ = p.shape
    H, N, W = RWKV_HEADS, RWKV_HEAD_DIM, BRANCH_WIDTH
    p_prev = jnp.pad(p, ((0, 0), (1, 0), (0, 0)))[:, :-1]
    p = p + mu * (p_prev - p)
    r, k, v, wl, al = jnp.split(p, (W, 2 * W, 3 * W, 3 * W + RWKV_LORA), axis=-1)
    w_log = -jax.nn.softplus(-(w0 + jnp.tanh(wl) @ w2)) - 0.5
    decay = jnp.exp(-jnp.exp(w_log.astype(jnp.float32)))
    a = jax.nn.sigmoid(a0 + al @ a2)

    def heads(t):
        return t.reshape(B, S, H, N).astype(jnp.float32)

    kk = heads(k * k_k)
    kk = kk / jnp.maximum(jnp.linalg.norm(kk, axis=-1, keepdims=True), 1e-12)
    k = k * (1.0 + (a - 1.0) * k_a)
    r_h, k_h, v_h, a_h, w_h = heads(r), heads(k), heads(v), heads(a), heads(decay)
    xs = tuple(jnp.moveaxis(t, 1, 0) for t in (r_h, w_h, k_h, v_h, -kk, kk * a_h))

    def step(state, inp):
        r_t, w_t, k_t, v_t, a_t, b_t = inp
        sa = jnp.einsum('bhvk,bhk->bhv', state, a_t)
        state = (state * w_t[:, :, None, :] + sa[..., None] * b_t[:, :, None, :]
                 + v_t[..., None] * k_t[:, :, None, :])
        return state, jnp.einsum('bhvk,bhk->bhv', state, r_t)

    s0 = jnp.zeros((B, H, N, N), jnp.float32)
    _, y = lax.scan(step, s0, xs)
    y = jnp.moveaxis(y, 0, 1)
    y_mu = jnp.mean(y, -1, keepdims=True)
    y_var = jnp.mean(jnp.square(y - y_mu), -1, keepdims=True)
    y = ((y - y_mu) * lax.rsqrt(y_var + RWKV_GN_EPS)).reshape(B, S, W) * lnx_g + lnx_b
    bonus = jnp.sum(r_h * k_h * r_k, axis=-1, keepdims=True) * v_h
    y = y + bonus.reshape(B, S, W)
    return y.astype(gate.dtype) * jax.nn.silu(gate)


def _causal_block_attention(q, k, v, scale):
    B, S, H, Dq = q.shape
    nb = S // Q_BLOCK
    qb = jnp.moveaxis(q.reshape(B, nb, Q_BLOCK, H, Dq), 1, 0)
    key_idx = jnp.arange(S)

    def one_block(args):
        q_blk, i = args
        s = jnp.einsum('bqhd,bkhd->bhqk', q_blk, k).astype(jnp.float32) * scale
        q_idx = i * Q_BLOCK + jnp.arange(Q_BLOCK)
        s = jnp.where(key_idx[None, :] <= q_idx[:, None], s, MASK_VALUE)
        pr = jax.nn.softmax(s, axis=-1).astype(v.dtype)
        return jnp.einsum('bhqk,bkhd->bqhd', pr, v)

    o = lax.map(one_block, (qb, jnp.arange(nb)))
    return jnp.moveaxis(o, 0, 1).reshape(B, S, H, v.shape[-1])


def _mla_branch(q_lat, kv_lat, k_pe, gate, cos, sin, q_norm, w_uq, kv_norm, w_ukv):
    B, S, _ = q_lat.shape
    H = MLA_HEADS
    q = (_rms_norm(q_lat, q_norm) @ w_uq).reshape(B, S, H, MLA_NOPE + MLA_ROPE)
    kv = (_rms_norm(kv_lat, kv_norm) @ w_ukv).reshape(B, S, H, MLA_NOPE + MLA_V)
    q_nope, q_pe = q[..., :MLA_NOPE], q[..., MLA_NOPE:]
    k_nope, v = kv[..., :MLA_NOPE], kv[..., MLA_NOPE:]
    q_pe = _rope(q_pe, cos[:, :, None, :], sin[:, :, None, :])
    k_pe = _rope(k_pe, cos, sin)
    q_full = jnp.concatenate([q_nope, q_pe], axis=-1)
    k_full = jnp.concatenate(
        [k_nope, jnp.broadcast_to(k_pe[:, :, None, :], (B, S, H, MLA_ROPE))], axis=-1)
    o = _causal_block_attention(q_full, k_full, v, (MLA_NOPE + MLA_ROPE) ** -0.5)
    return o.reshape(B, S, BRANCH_WIDTH) * jax.nn.silu(gate)


def _conformer_conv_branch(u, gate, conv_w, conv_b, ln_g, ln_b):
    val, glu_gate = jnp.split(u, 2, axis=-1)
    h = val * jax.nn.sigmoid(glu_gate)
    h = lax.conv_general_dilated(
        h, conv_w[:, None, :], window_strides=(1,), padding=[(CONV_KERNEL - 1, 0)],
        dimension_numbers=('NWC', 'WIO', 'NWC'), feature_group_count=BRANCH_WIDTH) + conv_b
    h = jax.nn.silu(_layer_norm(h, ln_g, ln_b))
    return h * jax.nn.silu(gate)


def _memory_xattn_branch(q, gate, mem, w_mem_kv):
    B, S, _ = q.shape
    M = mem.shape[1]
    kv = mem @ w_mem_kv
    k = kv[..., :BRANCH_WIDTH].reshape(B, M, XATTN_HEADS, XATTN_HEAD_DIM)
    v = kv[..., BRANCH_WIDTH:].reshape(B, M, XATTN_HEADS, XATTN_HEAD_DIM)
    qh = q.reshape(B, S, XATTN_HEADS, XATTN_HEAD_DIM)
    s = jnp.einsum('bshd,bmhd->bhsm', qh, k).astype(jnp.float32) * XATTN_HEAD_DIM ** -0.5
    pr = jax.nn.softmax(s, axis=-1).astype(v.dtype)
    o = jnp.einsum('bhsm,bmhd->bshd', pr, v).reshape(B, S, BRANCH_WIDTH)
    return o * jax.nn.silu(gate)


def setup_inputs(seed: int = 0) -> dict:
    key = jax.random.key(seed)
    ks = jax.random.split(key, 32)
    f32 = jnp.float32
    L, D, W = DEPTH, D_MODEL, BRANCH_WIDTH

    def nrm(k, shape, scale):
        return jax.random.normal(k, shape, f32) * scale

    x = jax.random.normal(ks[0], (BATCH, SEQ, D), f32)
    mem = jax.random.normal(ks[1], (BATCH, MEM_LEN, D), f32)
    start = jax.random.randint(ks[2], (BATCH, 1), 0, 4096, dtype=jnp.int32)
    positions = start + jnp.arange(SEQ, dtype=jnp.int32)[None, :]
    return {
        "x": x,
        "mem": mem,
        "positions": positions,
        "w_in": nrm(ks[3], (L, D, IN_COLS), D ** -0.5),
        "b_gate": nrm(ks[4], (L, N_BRANCH, D), 0.1),
        "rwkv_mu": jax.random.uniform(ks[5], (L, RWKV_SHIFT_COLS), f32),
        "rwkv_w0": jax.random.uniform(ks[6], (L, W), f32, -6.0, 0.0),
        "rwkv_w2": nrm(ks[7], (L, RWKV_LORA, W), 0.5 * RWKV_LORA ** -0.5),
        "rwkv_a0": nrm(ks[8], (L, W), 0.1),
        "rwkv_a2": nrm(ks[9], (L, RWKV_LORA, W), 0.5 * RWKV_LORA ** -0.5),
        "rwkv_k_k": 0.85 + nrm(ks[10], (L, W), 0.05),
        "rwkv_k_a": 1.0 + nrm(ks[11], (L, W), 0.05),
        "rwkv_r_k": nrm(ks[12], (L, RWKV_HEADS, RWKV_HEAD_DIM), 0.3),
        "rwkv_lnx_g": 1.0 + nrm(ks[13], (L, W), 0.02),
        "rwkv_lnx_b": nrm(ks[14], (L, W), 0.02),
        "mla_q_norm": 1.0 + nrm(ks[15], (L, MLA_Q_LORA), 0.02),
        "mla_w_uq": nrm(ks[16], (L, MLA_Q_LORA, MLA_HEADS * (MLA_NOPE + MLA_ROPE)), MLA_Q_LORA ** -0.5),
        "mla_kv_norm": 1.0 + nrm(ks[17], (L, MLA_KV_LORA), 0.02),
        "mla_w_ukv": nrm(ks[18], (L, MLA_KV_LORA, MLA_HEADS * (MLA_NOPE + MLA_V)), MLA_KV_LORA ** -0.5),
        "conv_w": nrm(ks[19], (L, CONV_KERNEL, W), CONV_KERNEL ** -0.5),
        "conv_b": nrm(ks[20], (L, W), 0.02),
        "conv_ln_g": 1.0 + nrm(ks[21], (L, W), 0.02),
        "conv_ln_b": nrm(ks[22], (L, W), 0.02),
        "xattn_w_mem_kv": nrm(ks[23], (L, D, 2 * W), D ** -0.5),
        "w_o_branch": nrm(ks[24], (L, N_BRANCH, W, D), DEEPNORM_BETA * W ** -0.5),
        "w_out": nrm(ks[25], (L, D, D), DEEPNORM_BETA * D ** -0.5),
        "ln_g": 1.0 + nrm(ks[26], (L, D), 0.02),
        "ln_b": nrm(ks[27], (L, D), 0.02),
    }


def reference(x, mem, positions, w_in, b_gate, rwkv_mu, rwkv_w0, rwkv_w2, rwkv_a0, rwkv_a2,
              rwkv_k_k, rwkv_k_a, rwkv_r_k, rwkv_lnx_g, rwkv_lnx_b, mla_q_norm, mla_w_uq,
              mla_kv_norm, mla_w_ukv, conv_w, conv_b, conv_ln_g, conv_ln_b, xattn_w_mem_kv,
              w_o_branch, w_out, ln_g, ln_b):
    B, S, D = x.shape
    inv_freq = ROPE_THETA ** (-jnp.arange(0, MLA_ROPE, 2, dtype=jnp.float32) / MLA_ROPE)
    ang = positions.astype(jnp.float32)[..., None] * inv_freq
    cos = jnp.cos(ang).astype(x.dtype)
    sin = jnp.sin(ang).astype(x.dtype)
    for l in range(DEPTH):
        h = x @ w_in[l]
        (rw_p, rw_g, q_lat, kv_lat, k_pe, mla_g, conv_u, conv_g, xq, xg,
         merge) = jnp.split(h, SPLIT_POINTS, axis=-1)
        y_rwkv = _rwkv7_branch(rw_p, rw_g, rwkv_mu[l], rwkv_w0[l], rwkv_w2[l], rwkv_a0[l],
                               rwkv_a2[l], rwkv_k_k[l], rwkv_k_a[l], rwkv_r_k[l],
                               rwkv_lnx_g[l], rwkv_lnx_b[l])
        y_mla = _mla_branch(q_lat, kv_lat, k_pe, mla_g, cos, sin, mla_q_norm[l], mla_w_uq[l],
                            mla_kv_norm[l], mla_w_ukv[l])
        y_conv = _conformer_conv_branch(conv_u, conv_g, conv_w[l], conv_b[l], conv_ln_g[l],
                                        conv_ln_b[l])
        y_mem = _memory_xattn_branch(xq, xg, mem, xattn_w_mem_kv[l])
        branches = jnp.stack([y_rwkv, y_mla, y_conv, y_mem], axis=2)
        proj = jnp.einsum('bsnc,ncd->bsnd', branches, w_o_branch[l])
        gates = jax.nn.sigmoid(merge.reshape(B, S, N_BRANCH, D) + b_gate[l])
        merged = jnp.sum(gates * proj, axis=2)
        out = merged @ w_out[l]
        x = _layer_norm(DEEPNORM_ALPHA * x + out, ln_g[l], ln_b[l])
    return x
```

```cpp
#include <hip/hip_runtime.h>
#include <hip/hip_cooperative_groups.h>
#include <cstdio>
#include <cstdint>
#include <cmath>
namespace cg = cooperative_groups;

typedef unsigned short bf16_t;
typedef short bf16x8 __attribute__((ext_vector_type(8)));
typedef float f32x4 __attribute__((ext_vector_type(4)));
typedef float f32x2 __attribute__((ext_vector_type(2)));
typedef unsigned u32x4 __attribute__((ext_vector_type(4)));
typedef unsigned u32x2 __attribute__((ext_vector_type(2)));

#define DEV __device__ __forceinline__

constexpr int NTHR = 512;
constexpr int T_TOK = 65536;
constexpr int SEQ = 2048;
constexpr int DM = 1024;
constexpr int IN_COLS = 10016;
constexpr int NH = 6016;
constexpr int NHP = 6144;
constexpr int LDS_MAIN = 147456;
constexpr int LDS_BYTES = LDS_MAIN + 16;
constexpr int LDSK = 80;

constexpr size_t sz_WIN = (size_t)NHP * 1024 * 2, sz_WM = (size_t)4096 * 1024 * 2, sz_WKVX = (size_t)1024 * 1024 * 2;
constexpr size_t sz_WUQ = (size_t)768 * 384 * 2, sz_WUK = (size_t)512 * 256 * 2, sz_WO = (size_t)4 * 1024 * 512 * 2, sz_WOUT = (size_t)1024 * 1024 * 2;
constexpr size_t sz_LORA = (size_t)512 * 64 * 2;
constexpr size_t R_WIN = 0, R_WM = R_WIN + sz_WIN, R_WKVX = R_WM + sz_WM, R_WUQ = R_WKVX + sz_WKVX, R_WUK = R_WUQ + sz_WUQ, R_WUV = R_WUK + sz_WUK;
constexpr size_t R_WO = R_WUV + sz_WUK, R_WOUT = R_WO + sz_WO, R_W2 = R_WOUT + sz_WOUT, R_A2 = R_W2 + sz_LORA, SZ_LW = ((R_A2 + sz_LORA + 4095) / 4096) * 4096;
constexpr size_t OFF_L1W = 0;
constexpr size_t OFF_MEMB = OFF_L1W + SZ_LW;
constexpr size_t OFF_CS = OFF_MEMB + (size_t)8192 * 1024 * 2;
constexpr size_t OFF_XK = OFF_CS + (size_t)T_TOK * 32 * 4;
constexpr size_t OFF_XVT = OFF_XK + (size_t)8192 * 512 * 2;
constexpr size_t OFF_RQ = OFF_XVT + (size_t)8192 * 512 * 2;
constexpr size_t OFF_RKV = OFF_RQ + (size_t)T_TOK * 4;
constexpr size_t OFF_Y = ((OFF_RKV + (size_t)T_TOK * 4 + 4095) / 4096) * 4096;
constexpr size_t OFF_QL = OFF_Y + (size_t)T_TOK * 2048 * 2;
constexpr size_t OFF_KVL = OFF_QL + (size_t)T_TOK * 384 * 2;
constexpr size_t OFF_KPE = OFF_KVL + (size_t)T_TOK * 256 * 2;
constexpr size_t OFF_CU = OFF_KPE + (size_t)T_TOK * 32 * 2;
constexpr size_t OFF_XQ = OFF_CU + (size_t)T_TOK * 512 * 2;
constexpr size_t OFF_RWP = OFF_XQ + (size_t)T_TOK * 512 * 2;
constexpr size_t OFF_EA = OFF_RWP + (size_t)T_TOK * 1664 * 2;
constexpr size_t OFF_XB1 = OFF_EA + (size_t)T_TOK * 1024 * 2;
constexpr size_t OFF_L0W = OFF_XB1 + (size_t)T_TOK * 1024 * 2 - SZ_LW;
constexpr size_t WS_END = OFF_XB1 + (size_t)T_TOK * 1024 * 2;
#define WOFF(NAME, l) (((l) == 0 ? OFF_L0W : OFF_L1W) + R_##NAME)
constexpr size_t OFF_MG = OFF_CU;
constexpr size_t OFF_QB = OFF_RWP;
constexpr size_t OFF_KN = OFF_QB + (size_t)T_TOK * 768 * 2;
constexpr size_t OFF_VTM = OFF_KN + (size_t)T_TOK * 512 * 2;
constexpr size_t OFF_OUT = OFF_RWP;
static_assert(OFF_VTM + (size_t)T_TOK * 512 * 2 <= OFF_XB1, "alias overflow");
static_assert(WS_END <= ((size_t)1 << 30), "workspace overflow");

struct Params {
    const float* x; const float* mem; const int* pos; const float* w_in; const float* b_gate; const float* rwkv_mu; const float* rwkv_w0;
    const float* rwkv_w2; const float* rwkv_a0; const float* rwkv_a2; const float* rwkv_k_k; const float* rwkv_k_a; const float* rwkv_r_k;
    const float* rwkv_lnx_g; const float* rwkv_lnx_b; const float* mla_q_norm; const float* mla_w_uq; const float* mla_kv_norm; const float* mla_w_ukv;
    const float* conv_w; const float* conv_b; const float* conv_ln_g; const float* conv_ln_b; const float* xattn_w; const float* w_o_branch;
    const float* w_out; const float* ln_g; const float* ln_b;
    float* out; char* ws;
};

typedef __bf16 bf16x2_t __attribute__((ext_vector_type(2)));
DEV unsigned pk_bf16(float lo, float hi) { const bf16x2_t v = __builtin_convertvector((f32x2){lo, hi}, bf16x2_t); return __builtin_bit_cast(unsigned, v); }
DEV bf16_t f2bf(float f) { return (bf16_t)(pk_bf16(f, 0.f) & 0xffffu); }
DEV float bflo(unsigned u) { return __uint_as_float(u << 16); }
DEV float bfhi(unsigned u) { return __uint_as_float(u & 0xffff0000u); }
DEV float bf2f(bf16_t h) { return __uint_as_float(((unsigned)h) << 16); }
DEV int otid() { int t = threadIdx.x; asm volatile("" : "+v"(t)); return t; }
extern __shared__ __attribute__((aligned(16))) char smem_g[];
DEV int obid() { int t = __builtin_amdgcn_readfirstlane(*(volatile int*)(smem_g + 147456 + 8)); asm volatile("" : "+s"(t)); return t; }
DEV int onb() { int t = gridDim.x; asm volatile("" : "+s"(t)); return t; }
DEV float sigmoidf_(float v) { return __builtin_amdgcn_rcpf(1.0f + __expf(-v)); }
DEV float siluf_(float v) { return v * __builtin_amdgcn_rcpf(1.0f + __expf(-v)); }
#define DPPF(v, ctrl) __builtin_bit_cast(float, __builtin_amdgcn_update_dpp(0, __builtin_bit_cast(int, (v)), (ctrl), 0xF, 0xF, true))
DEV float reduce8_dpp(float v) { v += DPPF(v, 0xB1); v += DPPF(v, 0x4E); v += DPPF(v, 0x141); return v; }
DEV float wave_sum(float v) {
#pragma unroll
    for (int o = 32; o >= 1; o >>= 1) v += __shfl_xor(v, o);
    return v;
}

template <int MI> DEV void mma_ktile(f32x4 (&acc)[MI][4], const bf16_t* sA, const bf16_t* sB, int wr, int wc, int fr, int fq) {
#pragma unroll
    for (int ks = 0; ks < 2; ++ks) {
        bf16x8 af[MI], bfr[4];
#pragma unroll
        for (int mi = 0; mi < MI; ++mi) af[mi] = *(const bf16x8*)(sA + (wr * 16 * MI + mi * 16 + fr) * LDSK + ks * 32 + fq * 8);
#pragma unroll
        for (int ni = 0; ni < 4; ++ni) bfr[ni] = *(const bf16x8*)(sB + (wc * 64 + ni * 16 + fr) * LDSK + ks * 32 + fq * 8);
#pragma unroll
        for (int mi = 0; mi < MI; ++mi)
#pragma unroll
            for (int ni = 0; ni < 4; ++ni) acc[mi][ni] = __builtin_amdgcn_mfma_f32_16x16x32_bf16(bfr[ni], af[mi], acc[mi][ni], 0, 0, 0);
    }
}

DEV void stage_rc(int b, int& R, int& C) { const int st = b >> 10, sb = b & 1023, swz = sb ^ (((sb >> 9) & 1) << 5); R = (st >> 1) * 16 + (swz >> 6); C = (st & 1) * 32 + ((swz & 63) >> 1); }
DEV void glds16(const bf16_t* g, char* l) { __builtin_amdgcn_global_load_lds((const unsigned*)g, (__attribute__((address_space(3))) unsigned*)l, 16, 0, 0); }
template <int MI, int PIPE = 1>
DEV void gemm_mainloop(f32x4 (&acc)[MI][4], const bf16_t* A, int lda, int m0, const bf16_t* Bt, int ldb, int n0, int K, char* smem, int rot = 0) {
    constexpr int NHA = MI / 2, STG = (NHA + 1) * 16384;
    const int tid = otid(), wid = tid >> 6, lane = tid & 63, wr = wid >> 1, wc = wid & 1, fr = lane & 15, fq = lane >> 4;
    int R0, C0, R1, C1; stage_rc(tid * 16, R0, C0); stage_rc(tid * 16 + 8192, R1, C1);
    const bf16_t* gA0 = A + (size_t)(m0 + R0) * lda + C0; const bf16_t* gA1 = A + (size_t)(m0 + R1) * lda + C1;
    const bf16_t* gB0 = Bt + (size_t)(n0 + R0) * ldb + C0; const bf16_t* gB1 = Bt + (size_t)(n0 + R1) * ldb + C1;
    char* l0 = smem + tid * 16;
    const int sw = (fr * 64 + fq * 16) ^ ((fr >> 3) << 5);
    const char* rdA = smem + (wr * MI) * 2048 + sw;
    const char* rdB = smem + NHA * 16384 + (wc * 4) * 2048 + sw;
    const int nk = K / 64;
#define STAGE(stg, kt) do { char* _l = l0 + (stg) * STG; int _k = (kt) + rot; _k = _k >= nk ? _k - nk : _k; _k *= 64; \
        _Pragma("unroll") for (int h = 0; h < NHA; ++h) { glds16(gA0 + (size_t)h * 128 * lda + _k, _l + h * 16384); glds16(gA1 + (size_t)h * 128 * lda + _k, _l + h * 16384 + 8192); } \
        glds16(gB0 + _k, _l + NHA * 16384); glds16(gB1 + _k, _l + NHA * 16384 + 8192); } while (0)
#define WAITV_TILE() do { if constexpr (MI == 4) asm volatile("s_waitcnt vmcnt(6)" ::: "memory"); else asm volatile("s_waitcnt vmcnt(4)" ::: "memory"); } while (0)
    __syncthreads();
    STAGE(0, 0); STAGE(1, 1); STAGE(2, 2);
    if constexpr (MI == 4) asm volatile("s_waitcnt vmcnt(12)" ::: "memory"); else asm volatile("s_waitcnt vmcnt(8)" ::: "memory");
    __builtin_amdgcn_s_barrier();
    asm volatile("" ::: "memory");
    int stg = 0;
    for (int kt = 0; kt < nk; ++kt) {
        const char* pa = rdA + stg * STG; const char* pb = rdB + stg * STG;
        bf16x8 af[2][MI], bfr[2][4];
#pragma unroll
        for (int mi = 0; mi < MI; ++mi) af[0][mi] = *(const bf16x8*)(pa + mi * 2048);
#pragma unroll
        for (int ni = 0; ni < 4; ++ni) bfr[0][ni] = *(const bf16x8*)(pb + ni * 2048);
        if constexpr (PIPE) {
#pragma unroll
            for (int mi = 0; mi < MI; ++mi) af[1][mi] = *(const bf16x8*)(pa + mi * 2048 + 1024);
#pragma unroll
            for (int ni = 0; ni < 4; ++ni) bfr[1][ni] = *(const bf16x8*)(pb + ni * 2048 + 1024);
            __builtin_amdgcn_sched_barrier(0);
        }
        __builtin_amdgcn_s_setprio(1);
#pragma unroll
        for (int mi = 0; mi < MI; ++mi)
#pragma unroll
            for (int ni = 0; ni < 4; ++ni) acc[mi][ni] = __builtin_amdgcn_mfma_f32_16x16x32_bf16(bfr[0][ni], af[0][mi], acc[mi][ni], 0, 0, 0);
        if constexpr (!PIPE) {
#pragma unroll
            for (int mi = 0; mi < MI; ++mi) af[1][mi] = *(const bf16x8*)(pa + mi * 2048 + 1024);
#pragma unroll
            for (int ni = 0; ni < 4; ++ni) bfr[1][ni] = *(const bf16x8*)(pb + ni * 2048 + 1024);
        }
        __builtin_amdgcn_sched_barrier(0);
        if (kt + 2 < nk) WAITV_TILE(); else asm volatile("s_waitcnt vmcnt(0)" ::: "memory");
        asm volatile("s_waitcnt lgkmcnt(0)" ::: "memory");
        __builtin_amdgcn_s_barrier();
        asm volatile("" ::: "memory");
        if (kt + 3 < nk) STAGE(stg, kt + 3);
        __builtin_amdgcn_sched_barrier(0);
#pragma unroll
        for (int mi = 0; mi < MI; ++mi)
#pragma unroll
            for (int ni = 0; ni < 4; ++ni) acc[mi][ni] = __builtin_amdgcn_mfma_f32_16x16x32_bf16(bfr[1][ni], af[1][mi], acc[mi][ni], 0, 0, 0);
        __builtin_amdgcn_s_setprio(0);
        stg = stg == 2 ? 0 : stg + 1;
    }
#undef STAGE
#undef WAITV_TILE
}

DEV void gemm256(f32x4 (&acc)[4][8], const bf16_t* A, int lda, int m0, const bf16_t* Bt, int ldb, int n0, int K, char* smem, int rot = 0) {
    const int tid = otid(), wid = tid >> 6, lane = tid & 63, wr = wid >> 1, wc = wid & 1, fr = lane & 15, fq = lane >> 4;
    int R, C; { const int b = tid * 16, st = b >> 10, sb = b & 1023, swz = sb ^ (((sb >> 9) & 1) << 5); R = st * 16 + (swz >> 6); C = (swz & 63) >> 1; }
    const bf16_t* gA = A + (size_t)(m0 + R) * lda + C;
    const bf16_t* gB = Bt + (size_t)(n0 + R) * ldb + C;
    const size_t hA = (size_t)128 * lda, hB = (size_t)128 * ldb;
    char* l0 = smem + tid * 16;
    const int sw = (fr * 64 + fq * 16) ^ ((fr >> 3) << 5);
    const char* rdA = smem + (wr * 4) * 1024 + sw;
    const char* rdB = smem + 16384 + wc * 8192 + sw;
    const int nk = K / 32;
#define STAGE(stg, kt) do { char* _l = l0 + (stg) * 32768; int _k = (kt) + rot; _k = _k >= nk ? _k - nk : _k; _k *= 32; glds16(gA + _k, _l); glds16(gA + hA + _k, _l + 8192); glds16(gB + _k, _l + 16384); glds16(gB + hB + _k, _l + 24576); } while (0)
    __syncthreads();
    STAGE(0, 0); STAGE(1, 1); STAGE(2, 2); STAGE(3, 3);
    asm volatile("s_waitcnt vmcnt(12)" ::: "memory");
    __builtin_amdgcn_s_barrier();
    asm volatile("" ::: "memory");
    for (int kt = 0; kt < nk; ++kt) {
        const int stg = kt & 3;
        const char* pa = rdA + stg * 32768; const char* pb = rdB + stg * 32768;
        bf16x8 af[4], bfr[8];
#pragma unroll
        for (int mi = 0; mi < 4; ++mi) af[mi] = *(const bf16x8*)(pa + mi * 1024);
#pragma unroll
        for (int ni = 0; ni < 8; ++ni) bfr[ni] = *(const bf16x8*)(pb + ni * 1024);
        __builtin_amdgcn_sched_barrier(0);
        __builtin_amdgcn_s_setprio(1);
#pragma unroll
        for (int ni = 0; ni < 4; ++ni)
#pragma unroll
            for (int mi = 0; mi < 4; ++mi) acc[mi][ni] = __builtin_amdgcn_mfma_f32_16x16x32_bf16(bfr[ni], af[mi], acc[mi][ni], 0, 0, 0);
        __builtin_amdgcn_sched_barrier(0);
        if (kt + 3 < nk) asm volatile("s_waitcnt vmcnt(8)" ::: "memory");
        else if (kt + 2 < nk) asm volatile("s_waitcnt vmcnt(4)" ::: "memory");
        else asm volatile("s_waitcnt vmcnt(0)" ::: "memory");
        asm volatile("s_waitcnt lgkmcnt(0)" ::: "memory");
        __builtin_amdgcn_s_barrier();
        asm volatile("" ::: "memory");
        if (kt + 4 < nk) STAGE(stg, kt + 4);
        __builtin_amdgcn_sched_barrier(0);
#pragma unroll
        for (int ni = 4; ni < 8; ++ni)
#pragma unroll
            for (int mi = 0; mi < 4; ++mi) acc[mi][ni] = __builtin_amdgcn_mfma_f32_16x16x32_bf16(bfr[ni], af[mi], acc[mi][ni], 0, 0, 0);
        __builtin_amdgcn_s_setprio(0);
    }
#undef STAGE
}
DEV void zero_acc8(f32x4 (&acc)[4][8]) {
#pragma unroll
    for (int mi = 0; mi < 4; ++mi)
#pragma unroll
        for (int ni = 0; ni < 8; ++ni) acc[mi][ni] = (f32x4){0.f, 0.f, 0.f, 0.f};
}
template <int MI> DEV void zero_acc(f32x4 (&acc)[MI][4]) {
#pragma unroll
    for (int mi = 0; mi < MI; ++mi)
#pragma unroll
        for (int ni = 0; ni < 4; ++ni) acc[mi][ni] = (f32x4){0.f, 0.f, 0.f, 0.f};
}
DEV void store4(bf16_t* p, f32x4 v) { *(u32x2*)p = (u32x2){pk_bf16(v[0], v[1]), pk_bf16(v[2], v[3])}; }

#define WAVE_IDS const int tid = otid(), wid = tid >> 6, lane = tid & 63, wr = wid >> 1, wc = wid & 1, fr = lane & 15, fq = lane >> 4; (void)wid; (void)lane; (void)wr; (void)wc; (void)fr; (void)fq;

template <class Map>
DEV void cvt_transpose(const float* src, int ld, int K, int Ndst, bf16_t* dst, Map map, const float* kscale, char* smem) {
    float* t = (float*)smem;
    const int ntn = Ndst / 64, ntk = K / 64, tid = otid();
    for (int tile = obid(); tile < ntn * ntk; tile += onb()) {
        const int tn = tile % ntn, tk = tile / ntn;
        __syncthreads();
#pragma unroll
        for (int i = 0; i < 2; ++i) {
            const int e = tid + i * NTHR, kk = e >> 4, n4 = (e & 15) * 4; const int sc = map(tn * 64 + n4);
            f32x4 v = (f32x4){0.f, 0.f, 0.f, 0.f};
            if (sc >= 0) { v = *(const f32x4*)(src + (size_t)(tk * 64 + kk) * ld + sc); if (kscale) v *= kscale[tk * 64 + kk]; }
            t[(n4 + 0) * 65 + kk] = v[0]; t[(n4 + 1) * 65 + kk] = v[1]; t[(n4 + 2) * 65 + kk] = v[2]; t[(n4 + 3) * 65 + kk] = v[3];
        }
        __syncthreads();
        { const int nn = tid >> 3, k8 = (tid & 7) * 8; const float* r = t + nn * 65 + k8;
          *(u32x4*)(dst + (size_t)(tn * 64 + nn) * K + tk * 64 + k8) = (u32x4){pk_bf16(r[0], r[1]), pk_bf16(r[2], r[3]), pk_bf16(r[4], r[5]), pk_bf16(r[6], r[7])}; }
    }
}
DEV int map_h(int n) {
    if (n < 2816) return n;
    if (n < 3328) return n + 32;
    if (n < 4352) { const int j = n - 3328, tile = j >> 7, jj = j & 127, sub = jj >> 4, i = jj & 15; return 3360 + tile * 64 + (sub >> 1) * 16 + i + ((sub & 1) ? 512 : 0); }
    if (n < 5888) return n + 32;
    if (n < 5920) return 2816 + (n - 5888);
    return -1;
}
DEV void phase_prologue(const Params& p, char* smem) {
    char* ws = p.ws;
    for (int l = 0; l < 2; ++l) {
        cvt_transpose(p.w_in + (size_t)l * 1024 * IN_COLS, IN_COLS, 1024, NH, (bf16_t*)(ws + WOFF(WIN, l)), [](int n) { return map_h(n); }, nullptr, smem);
        cvt_transpose(p.w_in + (size_t)l * 1024 * IN_COLS, IN_COLS, 1024, 4096, (bf16_t*)(ws + WOFF(WM, l)), [](int n) { return 5920 + n; }, nullptr, smem);
        cvt_transpose(p.xattn_w + (size_t)l * 1024 * 1024, 1024, 1024, 1024, (bf16_t*)(ws + WOFF(WKVX, l)), [](int n) { return n; }, nullptr, smem);
        cvt_transpose(p.mla_w_uq + (size_t)l * 384 * 768, 768, 384, 768, (bf16_t*)(ws + WOFF(WUQ, l)), [](int n) { return n; }, p.mla_q_norm + l * 384, smem);
        cvt_transpose(p.mla_w_ukv + (size_t)l * 256 * 1024, 1024, 256, 512, (bf16_t*)(ws + WOFF(WUK, l)), [](int n) { return (n >> 6) * 128 + (n & 63); }, p.mla_kv_norm + l * 256, smem);
        cvt_transpose(p.mla_w_ukv + (size_t)l * 256 * 1024, 1024, 256, 512, (bf16_t*)(ws + WOFF(WUV, l)), [](int n) { return (n >> 6) * 128 + 64 + (n & 63); }, p.mla_kv_norm + l * 256, smem);
        for (int n = 0; n < 4; ++n)
            cvt_transpose(p.w_o_branch + ((size_t)l * 4 + n) * 512 * 1024, 1024, 512, 1024, (bf16_t*)(ws + WOFF(WO, l)) + (size_t)n * 1024 * 512, [](int c) { return c; }, nullptr, smem);
        cvt_transpose(p.w_out + (size_t)l * 1024 * 1024, 1024, 1024, 1024, (bf16_t*)(ws + WOFF(WOUT, l)), [](int n) { return n; }, nullptr, smem);
        cvt_transpose(p.rwkv_w2 + (size_t)l * 64 * 512, 512, 64, 512, (bf16_t*)(ws + WOFF(W2, l)), [](int n) { return n; }, nullptr, smem);
        cvt_transpose(p.rwkv_a2 + (size_t)l * 64 * 512, 512, 64, 512, (bf16_t*)(ws + WOFF(A2, l)), [](int n) { return n; }, nullptr, smem);
    }
    {
        const size_t n4 = (size_t)T_TOK * 1024 / 4; bf16_t* xb = (bf16_t*)p.out;
        for (size_t i = (size_t)obid() * NTHR + otid(); i < n4; i += (size_t)onb() * NTHR) { const f32x4 v = *(const f32x4*)(p.x + i * 4); store4(xb + i * 4, v); }
    }
    {
        const size_t n4 = (size_t)8192 * 1024 / 4; bf16_t* mb = (bf16_t*)(ws + OFF_MEMB);
        for (size_t i = (size_t)obid() * NTHR + otid(); i < n4; i += (size_t)onb() * NTHR) { const f32x4 v = *(const f32x4*)(p.mem + i * 4); store4(mb + i * 4, v); }
    }
    {
        float* cs = (float*)(ws + OFF_CS);
        for (size_t i = (size_t)obid() * NTHR + otid(); i < (size_t)T_TOK * 16; i += (size_t)onb() * NTHR) {
            const int t = (int)(i >> 4), j = (int)(i & 15);
            const float inv = (float)exp2(-(double)j * (13.287712379549449 / 16.0));
            const float ang = (float)p.pos[t] * inv;
            double rev = (double)ang * 0.15915494309189535; rev -= rint(rev);
            cs[(size_t)t * 32 + j] = __builtin_amdgcn_cosf((float)rev); cs[(size_t)t * 32 + 16 + j] = __builtin_amdgcn_sinf((float)rev);
        }
    }
}

DEV void bounce_put(char* reg, int mi, int ns, int fr, int fq, f32x4 v) { *(u32x2*)(reg + (mi * 16 + fr) * 272 + (ns * 16 + fq * 4) * 2) = (u32x2){pk_bf16(v[0], v[1]), pk_bf16(v[2], v[3])}; }
template <int NS> DEV void bounce_flush(const char* reg, bf16_t* dst, int ld, int lane) {
    constexpr int CH = NS * 2, RPP = 64 / CH;
    const int chunk = lane % CH, rsub = lane / CH;
    __builtin_amdgcn_sched_barrier(0);
#pragma unroll
    for (int ps = 0; ps < CH; ++ps) { const int row = ps * RPP + rsub; *(u32x4*)(dst + (size_t)row * ld + chunk * 8) = *(const u32x4*)(reg + row * 272 + chunk * 16);
        if ((ps & 3) == 3) __builtin_amdgcn_sched_barrier(0); }
}
DEV u32x2 pk4(f32x4 v) { return (u32x2){pk_bf16(v[0], v[1]), pk_bf16(v[2], v[3])}; }
DEV void epi_h(const Params& p, const f32x4 (&acc)[4][8], int m0, int n0g, int, int, int, int, char* smem) {
    const int tid_ = otid(), wid__ = tid_ >> 6, wr = wid__ >> 1, wc = wid__ & 1, fr = tid_ & 15, fq = (tid_ & 63) >> 4;
    char* ws = p.ws; const int n0 = n0g + wc * 128, ti = n0 >> 7;
    if (ti >= 47) return;
    bf16_t* dst = nullptr; int ld = 0, coff = 0, mode = 0;
    if (ti < 13) { dst = (bf16_t*)(ws + OFF_RWP); ld = 1664; coff = n0; }
    else if (ti < 17) { dst = (bf16_t*)(ws + OFF_Y); ld = 2048; coff = n0 - 1664; mode = 1; }
    else if (ti < 20) { dst = (bf16_t*)(ws + OFF_QL); ld = 384; coff = n0 - 2176; }
    else if (ti < 22) { dst = (bf16_t*)(ws + OFF_KVL); ld = 256; coff = n0 - 2560; }
    else if (ti < 26) { dst = (bf16_t*)(ws + OFF_Y); ld = 2048; coff = 512 + n0 - 2816; mode = 1; }
    else if (ti < 34) { dst = (bf16_t*)(ws + OFF_CU); ld = 512; coff = (ti - 26) * 64; mode = 2; }
    else if (ti < 38) { dst = (bf16_t*)(ws + OFF_Y); ld = 2048; coff = 1024 + n0 - 4352; mode = 1; }
    else if (ti < 42) { dst = (bf16_t*)(ws + OFF_XQ); ld = 512; coff = n0 - 4864; }
    else if (ti < 46) { dst = (bf16_t*)(ws + OFF_Y); ld = 2048; coff = 1536 + n0 - 5376; mode = 1; }
    else { dst = (bf16_t*)(ws + OFF_KPE); ld = 32; mode = 3; }
    const int mbase = m0 + wr * 64;
    const int lane_ = fq * 16 + fr; char* reg = smem + (wr * 2 + wc) * 17408;
    if (mode <= 1) {
#pragma unroll
        for (int mi = 0; mi < 4; ++mi)
#pragma unroll
            for (int ni = 0; ni < 8; ++ni) { f32x4 v = acc[mi][ni]; if (mode == 1) { v[0] = siluf_(v[0]); v[1] = siluf_(v[1]); v[2] = siluf_(v[2]); v[3] = siluf_(v[3]); } bounce_put(reg, mi, ni, fr, fq, v); }
        bounce_flush<8>(reg, dst + (size_t)mbase * ld + coff, ld, lane_);
    } else if (mode == 2) {
#pragma unroll
        for (int mi = 0; mi < 4; ++mi)
#pragma unroll
            for (int pp = 0; pp < 4; ++pp) { const f32x4 a = acc[mi][2 * pp], g = acc[mi][2 * pp + 1]; f32x4 v;
                v[0] = a[0] * sigmoidf_(g[0]); v[1] = a[1] * sigmoidf_(g[1]); v[2] = a[2] * sigmoidf_(g[2]); v[3] = a[3] * sigmoidf_(g[3]); bounce_put(reg, mi, pp, fr, fq, v); }
        bounce_flush<4>(reg, dst + (size_t)mbase * ld + coff, ld, lane_);
    } else {
        const float* cs = (const float*)(ws + OFF_CS);
#pragma unroll
        for (int mi = 0; mi < 4; ++mi) { const size_t row = mbase + mi * 16 + fr;
            const f32x4 c = *(const f32x4*)(cs + row * 32 + fq * 4), s = *(const f32x4*)(cs + row * 32 + 16 + fq * 4);
            const f32x4 x1 = acc[mi][0], x2 = acc[mi][1];
            store4(dst + row * 32 + fq * 4, x1 * c - x2 * s); store4(dst + row * 32 + 16 + fq * 4, x1 * s + x2 * c); }
    }
}
template <int MI> DEV void epi_plain(const f32x4 (&acc)[MI][4], bf16_t* dst, int ld, int m0, int n0, int, int, int, int) {
    const int tid_ = otid(), wid__ = tid_ >> 6, wr = wid__ >> 1, wc = wid__ & 1, fr = tid_ & 15, fq = (tid_ & 63) >> 4;
#pragma unroll
    for (int mi = 0; mi < MI; ++mi) { const size_t row = m0 + wr * 16 * MI + mi * 16 + fr;
#pragma unroll
        for (int ni = 0; ni < 4; ++ni) store4(dst + row * ld + n0 + wc * 64 + ni * 16 + fq * 4, acc[mi][ni]); }
}
DEV void epi_plain8(const f32x4 (&acc)[4][8], bf16_t* dst, int ld, int m0, int n0, int, int, int, int, char* smem) {
    const int tid_ = otid(), wid__ = tid_ >> 6, wr = wid__ >> 1, wc = wid__ & 1, fr = tid_ & 15, fq = (tid_ & 63) >> 4;
    char* reg = smem + (wr * 2 + wc) * 17408;
#pragma unroll
    for (int mi = 0; mi < 4; ++mi)
#pragma unroll
        for (int ni = 0; ni < 8; ++ni) bounce_put(reg, mi, ni, fr, fq, acc[mi][ni]);
    bounce_flush<8>(reg, dst + (size_t)(m0 + wr * 64) * ld + n0 + wc * 128, ld, fq * 16 + fr);
}
DEV void phase1(const Params& p, int l, char* smem) {
    WAVE_IDS
    char* ws = p.ws;
    const bf16_t* xb = l == 0 ? (const bf16_t*)p.out : (const bf16_t*)(ws + OFF_XB1);
    const bf16_t* win = (const bf16_t*)(ws + WOFF(WIN, l));
    const bf16_t* wkv = (const bf16_t*)(ws + WOFF(WKVX, l));
    const bf16_t* memb = (const bf16_t*)(ws + OFF_MEMB);
    const int nb = onb(), bid = obid();
    const int n_main = 256 * 24, n_items = n_main + 128;
    for (int it = bid; it < n_items; it += nb) {
        asm volatile("" ::: "memory");
        f32x4 acc[4][8]; zero_acc8(acc);
        if (it < n_main) {
            const int xcd = it & 7, w = it >> 3;
            const int g = w >> 5, within = w & 31, mtg = g / 6, ntg = g % 6;
            const int mt = xcd * 32 + mtg * 8 + (within >> 2), nt = ntg * 4 + (within & 3);
            gemm256(acc, xb, 1024, mt * 256, win, 1024, nt * 256, 1024, smem, ((within & 3) * 8 + (within >> 2)) & 31);
            epi_h(p, acc, mt * 256, nt * 256, wr, wc, fr, fq, smem);
        } else if (it < n_main + 64) {
            const int j = it - n_main, mt = j >> 1, nt = j & 1;
            gemm256(acc, memb, 1024, mt * 256, wkv, 1024, nt * 256, 1024, smem);
            epi_plain8(acc, (bf16_t*)(ws + OFF_XK), 512, mt * 256, nt * 256, wr, wc, fr, fq, smem);
        } else {
            const int j = it - n_main - 64, b = j >> 1, mt = j & 1;
            gemm256(acc, wkv + (size_t)512 * 1024, 1024, mt * 256, memb + (size_t)b * 256 * 1024, 1024, 0, 1024, smem);
            epi_plain8(acc, (bf16_t*)(ws + OFF_XVT) + (size_t)b * 512 * 256, 256, mt * 256, 0, wr, wc, fr, fq, smem);
        }
    }
}

template <int DQK, int DV, bool CAUSAL, int MIA>
DEV void attn_item(const bf16_t* Q, int ldq, const bf16_t* K1, int ldk1, int D1, const bf16_t* K2, int ldk2, const bf16_t* Vt, int ldvt,
                   int nkt, int q0, float scale_log2, bf16_t* Yp, int ldy, char* smem, int dry = 0) {
    constexpr int LDK = DQK + 16, LDV = 72, KCH = DQK / 8;
    constexpr int NKC = 64 * KCH / NTHR + ((64 * KCH) % NTHR ? 1 : 0), NVC = DV * 8 / NTHR;
    bf16_t* sK = (bf16_t*)smem;
    bf16_t* sV = sK + 64 * LDK;
    constexpr int STG = 64 * LDK + DV * LDV;
    const int tid = otid(), w = tid >> 6, lane = tid & 63, fr = lane & 15, fq = lane >> 4;
    bf16x8 qf[MIA][DQK / 32];
#pragma unroll
    for (int mi = 0; mi < MIA; ++mi)
#pragma unroll
        for (int ks = 0; ks < DQK / 32; ++ks) qf[mi][ks] = *(const bf16x8*)(Q + (size_t)(w * 16 * MIA + mi * 16 + fr) * ldq + ks * 32 + fq * 8);
    f32x4 o[MIA][DV / 16];
#pragma unroll
    for (int mi = 0; mi < MIA; ++mi)
#pragma unroll
        for (int di = 0; di < DV / 16; ++di) o[mi][di] = (f32x4){0.f, 0.f, 0.f, 0.f};
    float mrun[MIA], lrun[MIA];
#pragma unroll
    for (int mi = 0; mi < MIA; ++mi) { mrun[mi] = -1e30f; lrun[mi] = 0.f; }
    u32x4 kreg[NKC], vreg[NVC];
    auto gload = [&](int kt) {
#pragma unroll
        for (int i = 0; i < NKC; ++i) { const int c = tid + i * NTHR; if (c < 64 * KCH) { const int row = c / KCH, col = (c % KCH) * 8;
            kreg[i] = col < D1 ? *(const u32x4*)(K1 + (size_t)(kt * 64 + row) * ldk1 + col) : *(const u32x4*)(K2 + (size_t)(kt * 64 + row) * ldk2 + (col - D1)); } }
#pragma unroll
        for (int i = 0; i < NVC; ++i) { const int c = tid + i * NTHR, d = c >> 3, ch = c & 7; vreg[i] = *(const u32x4*)(Vt + (size_t)d * ldvt + kt * 64 + ch * 8); }
    };
    auto sstore = [&](int buf) {
#pragma unroll
        for (int i = 0; i < NKC; ++i) { const int c = tid + i * NTHR; if (c < 64 * KCH) { const int row = c / KCH, col = (c % KCH) * 8; *(u32x4*)(sK + buf * STG + row * LDK + col) = kreg[i]; } }
#pragma unroll
        for (int i = 0; i < NVC; ++i) { const int c = tid + i * NTHR, d = c >> 3, ch = c & 7; *(u32x4*)(sV + buf * STG + d * LDV + ch * 8) = vreg[i]; }
    };
    gload(0);
    __syncthreads();
    sstore(0);
    if (nkt > 1) gload(1);
    __syncthreads();
    int slot = 0;
    for (int kt = 0; kt < nkt; ++kt) {
        const int nslot = slot == 2 ? 0 : slot + 1;
        const bf16_t* cK = sK + slot * STG; const bf16_t* cV = sV + slot * STG;
        if (kt + 1 < nkt) { sstore(nslot); if (kt + 2 < nkt) gload(kt + 2); }
        const bool live = !(CAUSAL && kt * 64 > q0 + w * 16 * MIA + 16 * MIA - 1);
        f32x4 s[MIA][4];
        if (live) {
#pragma unroll
        for (int mi = 0; mi < MIA; ++mi)
#pragma unroll
            for (int ni = 0; ni < 4; ++ni) s[mi][ni] = (f32x4){0.f, 0.f, 0.f, 0.f};
#pragma unroll
        for (int ks = 0; ks < DQK / 32; ++ks)
#pragma unroll
            for (int ni = 0; ni < 4; ++ni) { const bf16x8 kf = *(const bf16x8*)(cK + (ni * 16 + fr) * LDK + ks * 32 + fq * 8);
#pragma unroll
                for (int mi = 0; mi < MIA; ++mi) s[mi][ni] = __builtin_amdgcn_mfma_f32_16x16x32_bf16(kf, qf[mi][ks], s[mi][ni], 0, 0, 0); }
        }
        __syncthreads();
        slot = nslot;
        if (live) {
        bf16x8 pf[MIA][2];
#pragma unroll
        for (int mi = 0; mi < MIA; ++mi) {
            float mx = -1e30f;
            if (CAUSAL && kt * 64 + 63 > q0 + w * 16 * MIA) {
                const int qabs = q0 + w * 16 * MIA + mi * 16 + fr;
#pragma unroll
                for (int ni = 0; ni < 4; ++ni)
#pragma unroll
                    for (int r = 0; r < 4; ++r) { const int kabs = kt * 64 + ni * 16 + fq * 4 + r; if (kabs > qabs) s[mi][ni][r] = -1e30f; }
            }
#pragma unroll
            for (int ni = 0; ni < 4; ++ni) mx = fmaxf(mx, fmaxf(fmaxf(s[mi][ni][0], s[mi][ni][1]), fmaxf(s[mi][ni][2], s[mi][ni][3])));
            mx = fmaxf(mx, __shfl_xor(mx, 16)); mx = fmaxf(mx, __shfl_xor(mx, 32));
            const float mnew = fmaxf(mrun[mi], mx);
            const float mc = mnew * scale_log2;
            float ps = 0.f;
#pragma unroll
            for (int ni = 0; ni < 4; ++ni)
#pragma unroll
                for (int r = 0; r < 4; ++r) { const float pv = __builtin_amdgcn_exp2f(__builtin_fmaf(s[mi][ni][r], scale_log2, -mc)); s[mi][ni][r] = pv; ps += pv; }
            if (__builtin_amdgcn_ballot_w64(mnew > mrun[mi]) != 0ull) {
                const float alpha = __builtin_amdgcn_exp2f((mrun[mi] - mnew) * scale_log2);
                lrun[mi] *= alpha;
#pragma unroll
                for (int di = 0; di < DV / 16; ++di) o[mi][di] *= alpha;
            }
            mrun[mi] = mnew;
            lrun[mi] += ps;
#pragma unroll
            for (int s2 = 0; s2 < 2; ++s2) { const f32x4 a = s[mi][2 * s2], b = s[mi][2 * s2 + 1];
                const u32x4 pk = (u32x4){pk_bf16(a[0], a[1]), pk_bf16(a[2], a[3]), pk_bf16(b[0], b[1]), pk_bf16(b[2], b[3])};
                pf[mi][s2] = __builtin_bit_cast(bf16x8, pk); }
        }
#pragma unroll
        for (int di = 0; di < DV / 16; ++di)
#pragma unroll
            for (int s2 = 0; s2 < 2; ++s2) {
                const u32x2 v0 = *(const u32x2*)(cV + (di * 16 + fr) * LDV + s2 * 32 + fq * 4), v1 = *(const u32x2*)(cV + (di * 16 + fr) * LDV + s2 * 32 + 16 + fq * 4);
                const bf16x8 vf = __builtin_bit_cast(bf16x8, ((u32x4){v0[0], v0[1], v1[0], v1[1]}));
#pragma unroll
                for (int mi = 0; mi < MIA; ++mi) o[mi][di] = __builtin_amdgcn_mfma_f32_16x16x32_bf16(vf, pf[mi][s2], o[mi][di], 0, 0, 0);
            }
        }
    }
#pragma unroll
    for (int mi = 0; mi < MIA; ++mi) {
        float lt = lrun[mi]; lt += __shfl_xor(lt, 16); lt += __shfl_xor(lt, 32);
        const float inv = __builtin_amdgcn_rcpf(lt);
        bf16_t* yrow = Yp + (size_t)(w * 16 * MIA + mi * 16 + fr) * ldy;
#pragma unroll
        for (int di = 0; di < DV / 16; ++di) { bf16_t* yp = yrow + di * 16 + fq * 4; const u32x2 g = *(const u32x2*)yp;
            f32x4 v = o[mi][di] * inv; v[0] *= bflo(g[0]); v[1] *= bfhi(g[0]); v[2] *= bflo(g[1]); v[3] *= bfhi(g[1]); if (!dry) store4(yp, v); }
    }
}

DEV void lora_item(const Params& p, int l, int mt, int which, char* smem) {
    WAVE_IDS
    char* ws = p.ws;
    bf16_t* sA = (bf16_t*)smem; bf16_t* sB = sA + 256 * LDSK;
    const bf16_t* rwp = (const bf16_t*)(ws + OFF_RWP);
    const bf16_t* wt = (const bf16_t*)(ws + (which ? WOFF(A2, l) : WOFF(W2, l)));
    const int colb = 1536 + which * 64;
    const float* mu = p.rwkv_mu + l * 1664 + colb;
    const float* bias = (which ? p.rwkv_a0 : p.rwkv_w0) + l * 512;
    bf16_t* ea = (bf16_t*)(ws + OFF_EA) + which * 512;
    __syncthreads();
    const int crow = tid >> 3, cch = tid & 7;
    u32x4 breg[8];
#pragma unroll
    for (int i = 0; i < 8; ++i) breg[i] = *(const u32x4*)(wt + (size_t)(crow + i * 64) * 64 + cch * 8);
#pragma unroll
    for (int i = 0; i < 4; ++i) {
        const int row = crow + i * 64; const size_t t = (size_t)mt * 256 + row;
        const u32x4 cur = *(const u32x4*)(rwp + t * 1664 + colb + cch * 8);
        u32x4 prv = (u32x4){0u, 0u, 0u, 0u};
        if ((t & (SEQ - 1)) != 0) prv = *(const u32x4*)(rwp + (t - 1) * 1664 + colb + cch * 8);
        float v[8];
#pragma unroll
        for (int j = 0; j < 4; ++j) { const float c0 = bflo(cur[j]), c1 = bfhi(cur[j]), p0 = bflo(prv[j]), p1 = bfhi(prv[j]);
            v[2 * j] = c0 + mu[cch * 8 + 2 * j] * (p0 - c0); v[2 * j + 1] = c1 + mu[cch * 8 + 2 * j + 1] * (p1 - c1); }
        if (which == 0) {
#pragma unroll
            for (int j = 0; j < 8; ++j) { const float e2 = __expf(2.0f * v[j]); v[j] = 1.0f - 2.0f * __builtin_amdgcn_rcpf(e2 + 1.0f); }
        }
        *(u32x4*)(sA + row * LDSK + cch * 8) = (u32x4){pk_bf16(v[0], v[1]), pk_bf16(v[2], v[3]), pk_bf16(v[4], v[5]), pk_bf16(v[6], v[7])};
    }
#pragma unroll
    for (int i = 0; i < 8; ++i) *(u32x4*)(sB + (crow + i * 64) * LDSK + cch * 8) = breg[i];
    __syncthreads();
    for (int nt = 0; nt < 4; ++nt) {
        f32x4 acc[4][4]; zero_acc<4>(acc);
        mma_ktile<4>(acc, sA, sB + nt * 128 * LDSK, wr, wc, fr, fq);
#pragma unroll
        for (int mi = 0; mi < 4; ++mi) { const size_t row = (size_t)mt * 256 + wr * 64 + mi * 16 + fr;
#pragma unroll
            for (int ni = 0; ni < 4; ++ni) { const int col = nt * 128 + wc * 64 + ni * 16 + fq * 4; const f32x4 bz = *(const f32x4*)(bias + col); f32x4 v = acc[mi][ni] + bz;
#pragma unroll
                for (int r = 0; r < 4; ++r) { const float sg = sigmoidf_(v[r]); v[r] = which ? sg : 0.6065306597f * sg; }
                store4(ea + row * 1024 + col, v); } }
    }
}
DEV void conv_item(const Params& p, int l, int tile, char* smem, int dry) {
    char* ws = p.ws;
    bf16_t* sin_ = (bf16_t*)smem;
    float* sout = (float*)(smem + 62 * 1024);
    const bf16_t* cu = (const bf16_t*)(ws + OFF_CU);
    bf16_t* Y = (bf16_t*)(ws + OFF_Y);
    const int tid = otid(), wid = tid >> 6, lane = tid & 63;
    const int t0 = tile * 32, s0 = t0 & (SEQ - 1);
    __syncthreads();
    for (int c = tid; c < 62 * 64; c += NTHR) { const int row = c >> 6, ch = c & 63; const int srel = s0 - 30 + row;
        u32x4 v = (u32x4){0u, 0u, 0u, 0u};
        if (srel >= 0) v = *(const u32x4*)(cu + (size_t)(t0 - 30 + row) * 512 + ch * 8);
        *(u32x4*)(sin_ + row * 512 + ch * 8) = v; }
    float w[31];
#pragma unroll
    for (int j = 0; j < 31; ++j) w[j] = p.conv_w[((size_t)l * 31 + j) * 512 + tid];
    const float cb = p.conv_b[l * 512 + tid];
    __syncthreads();
    {
        float acc[32];
#pragma unroll
        for (int t = 0; t < 32; ++t) acc[t] = cb;
#pragma unroll
        for (int r = 0; r < 62; ++r) {
            const float xv = bf2f(sin_[r * 512 + tid]);
#pragma unroll
            for (int t = 0; t < 32; ++t) if (r - t >= 0 && r - t <= 30) acc[t] += w[r - t] * xv;
        }
#pragma unroll
        for (int t = 0; t < 32; ++t) sout[t * 512 + tid] = acc[t];
    }
    __syncthreads();
    const f32x4 g0 = *(const f32x4*)(p.conv_ln_g + l * 512 + lane * 8), g1 = *(const f32x4*)(p.conv_ln_g + l * 512 + lane * 8 + 4);
    const f32x4 b0 = *(const f32x4*)(p.conv_ln_b + l * 512 + lane * 8), b1 = *(const f32x4*)(p.conv_ln_b + l * 512 + lane * 8 + 4);
#pragma unroll 1
    for (int t = wid; t < 32; t += 8) {
        const f32x4 x0 = *(const f32x4*)(sout + t * 512 + lane * 8), x1 = *(const f32x4*)(sout + t * 512 + lane * 8 + 4);
        float sm = (x0[0] + x0[1]) + (x0[2] + x0[3]) + (x1[0] + x1[1]) + (x1[2] + x1[3]);
        const float mean = wave_sum(sm) * (1.0f / 512.0f);
        const f32x4 d0 = x0 - mean, d1 = x1 - mean;
        float sq = (d0[0] * d0[0] + d0[1] * d0[1]) + (d0[2] * d0[2] + d0[3] * d0[3]) + (d1[0] * d1[0] + d1[1] * d1[1]) + (d1[2] * d1[2] + d1[3] * d1[3]);
        const float rstd = rsqrtf(wave_sum(sq) * (1.0f / 512.0f) + 1e-5f);
        bf16_t* yp = Y + (size_t)(t0 + t) * 2048 + 1024 + lane * 8;
        const u32x4 g = *(const u32x4*)yp;
        f32x4 y0 = d0 * rstd * g0 + b0, y1 = d1 * rstd * g1 + b1;
        float o[8];
#pragma unroll
        for (int j = 0; j < 4; ++j) { o[j] = siluf_(y0[j]); o[4 + j] = siluf_(y1[j]); }
#pragma unroll
        for (int j = 0; j < 4; ++j) { o[2 * j] *= bflo(g[j]); o[2 * j + 1] *= bfhi(g[j]); }
        if (!dry) *(u32x4*)yp = (u32x4){pk_bf16(o[0], o[1]), pk_bf16(o[2], o[3]), pk_bf16(o[4], o[5]), pk_bf16(o[6], o[7])};
    }
}
DEV void phase2(const Params& p, int l, char* smem, int dry = 0, int parts = 15) {
    char* ws = p.ws;
    const int nb = onb(), bid = obid();
    if (parts & 1) for (int it = bid; it < 512; it += nb) { asm volatile("" ::: "memory"); lora_item(p, l, it >> 1, it & 1, smem); }
    if (parts & 2) for (int j = bid; j < 2048; j += nb) {
        asm volatile("" ::: "memory");
        const int qb = j & 15, h = (j >> 4) & 3, b = j >> 6;
        const size_t t0 = (size_t)b * SEQ + qb * 128;
        attn_item<128, 128, false, 1>((const bf16_t*)(ws + OFF_XQ) + t0 * 512 + h * 128, 512,
                                      (const bf16_t*)(ws + OFF_XK) + (size_t)b * 256 * 512 + h * 128, 512, 128, nullptr, 0,
                                      (const bf16_t*)(ws + OFF_XVT) + ((size_t)b * 512 + h * 128) * 256, 256,
                                      4, 0, 0.08838834764831845f * 1.4426950408889634f, (bf16_t*)(ws + OFF_Y) + t0 * 2048 + 1536 + h * 128, 2048, smem, dry);
    }
    if (parts & 4) for (int it = bid; it < 2048; it += nb) { asm volatile("" ::: "memory"); conv_item(p, l, it, smem, dry); }
    if (!(parts & 8)) return;
    const int wid = otid() >> 6, lane = otid() & 63, li = lane & 15, tg = lane >> 4;
    const bf16_t* ql = (const bf16_t*)(ws + OFF_QL); const bf16_t* kvl = (const bf16_t*)(ws + OFF_KVL);
    float* rq = (float*)(ws + OFF_RQ); float* rkv = (float*)(ws + OFF_RKV);
    auto sq8 = [](u32x4 u) { float s = 0.f;
#pragma unroll
        for (int j = 0; j < 4; ++j) { const float a = bflo(u[j]), b = bfhi(u[j]); s += a * a + b * b; } return s; };
#pragma unroll 2
    for (int t = (bid * 8 + wid) * 4 + tg; t < T_TOK; t += nb * 32) {
        const u32x4* qp = (const u32x4*)(ql + (size_t)t * 384); const u32x4* kp = (const u32x4*)(kvl + (size_t)t * 256);
        const u32x4 q0 = qp[li], q1 = qp[li + 16], q2 = qp[li + 32], k0 = kp[li], k1 = kp[li + 16];
        float s = sq8(q0) + sq8(q1) + sq8(q2), s2 = sq8(k0) + sq8(k1);
        s += DPPF(s, 0xB1); s += DPPF(s, 0x4E); s += DPPF(s, 0x141); s += DPPF(s, 0x140);
        s2 += DPPF(s2, 0xB1); s2 += DPPF(s2, 0x4E); s2 += DPPF(s2, 0x141); s2 += DPPF(s2, 0x140);
        if (li == 0) { rq[t] = rsqrtf(s * (1.0f / 384.0f) + 1e-6f); rkv[t] = rsqrtf(s2 * (1.0f / 256.0f) + 1e-6f); }
    }
}

DEV void phase3(const Params& p, int l, char* smem, int dry = 0) {
    char* ws = p.ws;
    float* op = (float*)smem;
    float* ybuf = op + 2 * 32 * 384;
    float* bon = ybuf + 2 * 32 * 64;
    const bf16_t* rwp = (const bf16_t*)(ws + OFF_RWP);
    const bf16_t* ea = (const bf16_t*)(ws + OFF_EA);
    bf16_t* Y = (bf16_t*)(ws + OFF_Y);
    const int tid = otid();
    for (int chain = obid(); chain < 256; chain += onb()) {
        asm volatile("" ::: "memory");
        const int b = chain >> 3, h = chain & 7;
        __syncthreads();
        if (__builtin_amdgcn_readfirstlane(tid) >= 256) {
            const int pt = tid - 256, tok = pt >> 3, g = pt & 7, c0 = h * 64 + g * 8;
            float mur[8], muk[8], muv[8], kk_[8], ka_[8], rk_[8], lg[8], lb[8];
#pragma unroll
            for (int j = 0; j < 8; ++j) {
                mur[j] = p.rwkv_mu[l * 1664 + c0 + j]; muk[j] = p.rwkv_mu[l * 1664 + 512 + c0 + j]; muv[j] = p.rwkv_mu[l * 1664 + 1024 + c0 + j];
                kk_[j] = p.rwkv_k_k[l * 512 + c0 + j]; ka_[j] = p.rwkv_k_a[l * 512 + c0 + j]; rk_[j] = p.rwkv_r_k[l * 512 + c0 + j];
                lg[j] = p.rwkv_lnx_g[l * 512 + c0 + j]; lb[j] = p.rwkv_lnx_b[l * 512 + c0 + j];
            }
            auto prep = [&](int ci) {
                const int buf = ci & 1, s = ci * 32 + tok; const size_t t = (size_t)b * SEQ + s;
                const bf16_t* row = rwp + t * 1664 + c0;
                const u32x4 rc = *(const u32x4*)row, kc = *(const u32x4*)(row + 512), vc = *(const u32x4*)(row + 1024);
                u32x4 rp = (u32x4){0u, 0u, 0u, 0u}, kp = rp, vp = rp;
                if (s > 0) { rp = *(const u32x4*)(row - 1664); kp = *(const u32x4*)(row - 1664 + 512); vp = *(const u32x4*)(row - 1664 + 1024); }
                const u32x4 ee = *(const u32x4*)(ea + t * 1024 + c0), aa = *(const u32x4*)(ea + t * 1024 + 512 + c0);
                float r[8], k[8], v[8], kk[8], e[8], a[8];
#pragma unroll
                for (int j = 0; j < 4; ++j) {
                    float c, q;
                    c = bflo(rc[j]); q = bflo(rp[j]); r[2 * j] = c + mur[2 * j] * (q - c); c = bfhi(rc[j]); q = bfhi(rp[j]); r[2 * j + 1] = c + mur[2 * j + 1] * (q - c);
                    c = bflo(kc[j]); q = bflo(kp[j]); k[2 * j] = c + muk[2 * j] * (q - c); c = bfhi(kc[j]); q = bfhi(kp[j]); k[2 * j + 1] = c + muk[2 * j + 1] * (q - c);
                    c = bflo(vc[j]); q = bflo(vp[j]); v[2 * j] = c + muv[2 * j] * (q - c); c = bfhi(vc[j]); q = bfhi(vp[j]); v[2 * j + 1] = c + muv[2 * j + 1] * (q - c);
                    e[2 * j] = bflo(ee[j]); e[2 * j + 1] = bfhi(ee[j]); a[2 * j] = bflo(aa[j]); a[2 * j + 1] = bfhi(aa[j]);
                }
                float ss = 0.f;
#pragma unroll
                for (int j = 0; j < 8; ++j) { kk[j] = k[j] * kk_[j]; ss += kk[j] * kk[j]; }
                ss += __shfl_xor(ss, 1); ss += __shfl_xor(ss, 2); ss += __shfl_xor(ss, 4);
                const float inv = 1.0f / fmaxf(sqrtf(ss), 1e-12f);
                float* o = op + (size_t)(buf * 32 + tok) * 384 + g * 8;
                float bs = 0.f;
#pragma unroll
                for (int j = 0; j < 8; ++j) {
                    const float kn = kk[j] * inv, km = k[j] * (1.0f + (a[j] - 1.0f) * ka_[j]);
                    o[j] = -kn; o[64 + j] = __expf(-e[j]); o[128 + j] = kn * a[j]; o[192 + j] = km; o[256 + j] = r[j]; o[320 + j] = v[j];
                    bs += r[j] * km * rk_[j];
                }
                bs += __shfl_xor(bs, 1); bs += __shfl_xor(bs, 2); bs += __shfl_xor(bs, 4);
                if (g == 0) bon[buf * 32 + tok] = bs;
            };
            auto post = [&](int ci) {
                const int buf = ci & 1, s = ci * 32 + tok; const size_t t = (size_t)b * SEQ + s;
                const float* yb = ybuf + (buf * 32 + tok) * 64 + g * 8;
                float y[8]; float sm = 0.f;
#pragma unroll
                for (int j = 0; j < 8; ++j) { y[j] = yb[j]; sm += y[j]; }
                sm += __shfl_xor(sm, 1); sm += __shfl_xor(sm, 2); sm += __shfl_xor(sm, 4);
                const float mean = sm * (1.0f / 64.0f); float sq = 0.f;
#pragma unroll
                for (int j = 0; j < 8; ++j) { y[j] -= mean; sq += y[j] * y[j]; }
                sq += __shfl_xor(sq, 1); sq += __shfl_xor(sq, 2); sq += __shfl_xor(sq, 4);
                const float rstd = rsqrtf(sq * (1.0f / 64.0f) + 64e-5f);
                const float bo = bon[buf * 32 + tok];
                const float* vv = op + (size_t)(buf * 32 + tok) * 384 + 320 + g * 8;
                bf16_t* yp = Y + t * 2048 + c0;
                const u32x4 gg = *(const u32x4*)yp;
                float o[8];
#pragma unroll
                for (int j = 0; j < 8; ++j) o[j] = y[j] * rstd * lg[j] + lb[j] + bo * vv[j];
#pragma unroll
                for (int j = 0; j < 4; ++j) { o[2 * j] *= bflo(gg[j]); o[2 * j + 1] *= bfhi(gg[j]); }
                if (!dry) *(u32x4*)yp = (u32x4){pk_bf16(o[0], o[1]), pk_bf16(o[2], o[3]), pk_bf16(o[4], o[5]), pk_bf16(o[6], o[7])};
            };
            prep(0);
            __syncthreads();
            for (int ci = 0; ci < 64; ++ci) {
                if (ci >= 1) post(ci - 1);
                if (ci + 1 < 64) prep(ci + 1);
                __syncthreads();
            }
            post(63);
        } else {
            const int vp = tid >> 3, kq = tid & 7;
            f32x2 st[2][4];
#pragma unroll
            for (int i = 0; i < 2; ++i)
#pragma unroll
                for (int j = 0; j < 4; ++j) st[i][j] = (f32x2){0.f, 0.f};
            __syncthreads();
            for (int ci = 0; ci < 64; ++ci) {
                const int buf = ci & 1;
                const float* base0 = op + (size_t)buf * 32 * 384 + kq * 8;
                float* yb = ybuf + buf * 32 * 64 + 2 * vp;
#pragma unroll 4
                for (int tok = 0; tok < 32; ++tok) {
                    const float* bs = base0 + tok * 384;
                    const f32x4 a0 = *(const f32x4*)bs, a1 = *(const f32x4*)(bs + 4);
                    const f32x4 w0 = *(const f32x4*)(bs + 64), w1 = *(const f32x4*)(bs + 68);
                    const f32x4 b0 = *(const f32x4*)(bs + 128), b1 = *(const f32x4*)(bs + 132);
                    const f32x4 k0 = *(const f32x4*)(bs + 192), k1 = *(const f32x4*)(bs + 196);
                    const f32x4 r0 = *(const f32x4*)(bs + 256), r1 = *(const f32x4*)(bs + 260);
                    const f32x2 vv = *(const f32x2*)(op + (size_t)(buf * 32 + tok) * 384 + 320 + 2 * vp);
                    const f32x2 av[4] = {(f32x2){a0[0], a0[1]}, (f32x2){a0[2], a0[3]}, (f32x2){a1[0], a1[1]}, (f32x2){a1[2], a1[3]}};
                    const f32x2 wv[4] = {(f32x2){w0[0], w0[1]}, (f32x2){w0[2], w0[3]}, (f32x2){w1[0], w1[1]}, (f32x2){w1[2], w1[3]}};
                    const f32x2 bv[4] = {(f32x2){b0[0], b0[1]}, (f32x2){b0[2], b0[3]}, (f32x2){b1[0], b1[1]}, (f32x2){b1[2], b1[3]}};
                    const f32x2 kv[4] = {(f32x2){k0[0], k0[1]}, (f32x2){k0[2], k0[3]}, (f32x2){k1[0], k1[1]}, (f32x2){k1[2], k1[3]}};
                    const f32x2 rv[4] = {(f32x2){r0[0], r0[1]}, (f32x2){r0[2], r0[3]}, (f32x2){r1[0], r1[1]}, (f32x2){r1[2], r1[3]}};
                    float yo[2];
#pragma unroll
                    for (int i = 0; i < 2; ++i) {
                        f32x2 sa2 = st[i][0] * av[0]; sa2 += st[i][1] * av[1]; sa2 += st[i][2] * av[2]; sa2 += st[i][3] * av[3];
                        const float sa = reduce8_dpp(sa2[0] + sa2[1]);
                        const float vi = vv[i];
                        f32x2 y2 = (f32x2){0.f, 0.f};
#pragma unroll
                        for (int j = 0; j < 4; ++j) { st[i][j] = st[i][j] * wv[j] + sa * bv[j] + vi * kv[j]; y2 += st[i][j] * rv[j]; }
                        yo[i] = reduce8_dpp(y2[0] + y2[1]);
                    }
                    if (kq == 0) *(f32x2*)(yb + tok * 64) = (f32x2){yo[0], yo[1]};
                }
                __syncthreads();
            }
        }
    }
}

DEV void phase4(const Params& p, int l, char* smem) {
    WAVE_IDS
    char* ws = p.ws;
    const bf16_t* ql = (const bf16_t*)(ws + OFF_QL); const bf16_t* kvl = (const bf16_t*)(ws + OFF_KVL);
    const float* rq = (const float*)(ws + OFF_RQ); const float* rkv = (const float*)(ws + OFF_RKV);
    const float* cs = (const float*)(ws + OFF_CS);
    bf16_t* qb = (bf16_t*)(ws + OFF_QB); bf16_t* kn = (bf16_t*)(ws + OFF_KN); bf16_t* vtm = (bf16_t*)(ws + OFF_VTM);
    const bf16_t* wuq = (const bf16_t*)(ws + WOFF(WUQ, l)); const bf16_t* wuk = (const bf16_t*)(ws + WOFF(WUK, l)); const bf16_t* wuv = (const bf16_t*)(ws + WOFF(WUV, l));
    const int n_items = 768 + 512 + 512;
    for (int it = obid(); it < n_items; it += onb()) {
        asm volatile("" ::: "memory");
        f32x4 acc[4][8]; zero_acc8(acc);
        if (it < 768) {
            const int mt = it / 3, nt = it % 3, m0 = mt * 256, n0 = nt * 256 + wc * 128;
            gemm256(acc, ql, 384, m0, wuq, 384, nt * 256, 384, smem);
#pragma unroll
            for (int mi = 0; mi < 4; ++mi) { const size_t row = m0 + wr * 64 + mi * 16 + fr; const float rs = rq[row];
                const f32x4 c = *(const f32x4*)(cs + row * 32 + fq * 4), s = *(const f32x4*)(cs + row * 32 + 16 + fq * 4);
#pragma unroll
                for (int ni = 0; ni < 8; ++ni) acc[mi][ni] *= rs;
#pragma unroll
                for (int pp = 0; pp < 4; ++pp) { const int cs0 = n0 + pp * 32; if ((cs0 % 96) == 64) { const f32x4 x1 = acc[mi][2 * pp], x2 = acc[mi][2 * pp + 1]; acc[mi][2 * pp] = x1 * c - x2 * s; acc[mi][2 * pp + 1] = x1 * s + x2 * c; } }
#pragma unroll
                for (int ni = 0; ni < 8; ++ni) store4(qb + row * 768 + n0 + ni * 16 + fq * 4, acc[mi][ni]); }
        } else if (it < 1280) {
            const int j = it - 768, mt = j >> 1, nt = j & 1, m0 = mt * 256, n0 = nt * 256 + wc * 128;
            gemm256(acc, kvl, 256, m0, wuk, 256, nt * 256, 256, smem);
#pragma unroll
            for (int mi = 0; mi < 4; ++mi) { const size_t row = m0 + wr * 64 + mi * 16 + fr; const float rs = rkv[row];
#pragma unroll
                for (int ni = 0; ni < 8; ++ni) store4(kn + row * 512 + n0 + ni * 16 + fq * 4, acc[mi][ni] * rs); }
        } else {
            const int j = it - 1280, b = j >> 4, mt = (j >> 3) & 1, nt = j & 7, m0 = mt * 256, n0 = nt * 256 + wc * 128;
            gemm256(acc, wuv, 256, m0, kvl + (size_t)b * SEQ * 256, 256, nt * 256, 256, smem);
#pragma unroll
            for (int ni = 0; ni < 8; ++ni) { const int col = n0 + ni * 16 + fq * 4; const f32x4 rs = *(const f32x4*)(rkv + (size_t)b * SEQ + col);
#pragma unroll
                for (int mi = 0; mi < 4; ++mi) { const size_t row = m0 + wr * 64 + mi * 16 + fr; store4(vtm + ((size_t)b * 512 + row) * SEQ + col, acc[mi][ni] * rs); } }
        }
    }
}

DEV void phase5(const Params& p, char* smem, int dry = 0) {
    char* ws = p.ws;
    for (int it = obid(); it < 2048; it += onb()) {
        asm volatile("" ::: "memory");
        const int bh = it & 255, qb = 7 - (it >> 8), b = bh >> 3, h = bh & 7;
        const size_t t0 = (size_t)b * SEQ + qb * 256;
        __syncthreads();
        attn_item<96, 64, true, 2>((const bf16_t*)(ws + OFF_QB) + t0 * 768 + h * 96, 768,
                                (const bf16_t*)(ws + OFF_KN) + (size_t)b * SEQ * 512 + h * 64, 512, 64,
                                (const bf16_t*)(ws + OFF_KPE) + (size_t)b * SEQ * 32, 32,
                                (const bf16_t*)(ws + OFF_VTM) + ((size_t)b * 512 + h * 64) * SEQ, SEQ,
                                (qb + 1) * 4, qb * 256, 0.10206207261596577f * 1.4426950408889634f, (bf16_t*)(ws + OFF_Y) + t0 * 2048 + 512 + h * 64, 2048, smem, dry);
    }
}

DEV void phase6(const Params& p, int l, char* smem) {
    WAVE_IDS
    char* ws = p.ws;
    const bf16_t* xb = l == 0 ? (const bf16_t*)p.out : (const bf16_t*)(ws + OFF_XB1);
    const bf16_t* wm = (const bf16_t*)(ws + WOFF(WM, l)); const bf16_t* wo = (const bf16_t*)(ws + WOFF(WO, l));
    const bf16_t* Y = (const bf16_t*)(ws + OFF_Y); bf16_t* mg = (bf16_t*)(ws + OFF_MG);
    for (int it = obid(); it < 256 * 8; it += onb()) {
        asm volatile("" ::: "memory");
        const int xcd = it & 7, w = it >> 3, mt = xcd * 32 + (w >> 5) * 4 + ((w & 31) >> 3), nt = w & 7, m0 = mt * 256, n0 = nt * 128;
        f32x4 mrg[4][4]; zero_acc<4>(mrg);
        for (int n = 0; n < 4; ++n) {
            u32x2 gpk[4][4];
            {
                f32x4 ag[4][4]; zero_acc<4>(ag);
                gemm_mainloop<4, 1>(ag, xb, 1024, m0, wm + (size_t)n * 1024 * 1024, 1024, n0, 1024, smem, ((w & 7) * 2 + ((w >> 3) & 1)) & 15);
#pragma unroll
                for (int ni = 0; ni < 4; ++ni) { const f32x4 bz = *(const f32x4*)(p.b_gate + ((size_t)l * 4 + n) * 1024 + n0 + wc * 64 + ni * 16 + fq * 4);
#pragma unroll
                    for (int mi = 0; mi < 4; ++mi) { const f32x4 v = ag[mi][ni] + bz; gpk[mi][ni] = (u32x2){pk_bf16(sigmoidf_(v[0]), sigmoidf_(v[1])), pk_bf16(sigmoidf_(v[2]), sigmoidf_(v[3]))}; } }
            }
            f32x4 ap[4][4]; zero_acc<4>(ap);
            gemm_mainloop<4, 0>(ap, Y + n * 512, 2048, m0, wo + (size_t)n * 1024 * 512, 512, n0, 512, smem, w & 7);
#pragma unroll
            for (int mi = 0; mi < 4; ++mi)
#pragma unroll
                for (int ni = 0; ni < 4; ++ni) { const u32x2 g = gpk[mi][ni]; mrg[mi][ni] += (f32x4){bflo(g[0]), bfhi(g[0]), bflo(g[1]), bfhi(g[1])} * ap[mi][ni]; }
        }
        epi_plain<4>(mrg, mg, 1024, m0, n0, wr, wc, fr, fq);
    }
}
DEV void phase7(const Params& p, int l, char* smem) {
    WAVE_IDS
    char* ws = p.ws;
    const bf16_t* mg = (const bf16_t*)(ws + OFF_MG); const bf16_t* wout = (const bf16_t*)(ws + WOFF(WOUT, l)); bf16_t* o = (bf16_t*)(ws + OFF_OUT);
    for (int it = obid(); it < 256 * 4; it += onb()) {
        asm volatile("" ::: "memory");
        const int xcd = it & 7, w = it >> 3, mt = xcd * 32 + (w >> 2), nt = w & 3;
        f32x4 acc[4][8]; zero_acc8(acc);
        gemm256(acc, mg, 1024, mt * 256, wout, 1024, nt * 256, 1024, smem, ((w & 3) * 8 + ((w >> 2) & 7)) & 31);
        epi_plain8(acc, o, 1024, mt * 256, nt * 256, wr, wc, fr, fq, smem);
    }
}
DEV void phase8(const Params& p, int l) {
    char* ws = p.ws;
    const float* xin = l == 0 ? p.x : p.out; const bf16_t* o = (const bf16_t*)(ws + OFF_OUT);
    const int wid = otid() >> 6, lane = otid() & 63;
    const float alpha = 1.4142135623730951f;
    for (int t = obid() * 8 + wid; t < T_TOK; t += onb() * 8) {
        f32x4 v[4]; float sm = 0.f;
#pragma unroll
        for (int j = 0; j < 4; ++j) { const int col = j * 256 + lane * 4; const f32x4 xv = *(const f32x4*)(xin + (size_t)t * 1024 + col); const u32x2 ov = *(const u32x2*)(o + (size_t)t * 1024 + col);
            v[j] = xv * alpha + (f32x4){bflo(ov[0]), bfhi(ov[0]), bflo(ov[1]), bfhi(ov[1])}; sm += (v[j][0] + v[j][1]) + (v[j][2] + v[j][3]); }
        const float mean = wave_sum(sm) * (1.0f / 1024.0f); float sq = 0.f;
#pragma unroll
        for (int j = 0; j < 4; ++j) { v[j] -= mean; sq += (v[j][0] * v[j][0] + v[j][1] * v[j][1]) + (v[j][2] * v[j][2] + v[j][3] * v[j][3]); }
        const float rstd = rsqrtf(wave_sum(sq) * (1.0f / 1024.0f) + 1e-5f);
#pragma unroll
        for (int j = 0; j < 4; ++j) { const int col = j * 256 + lane * 4; const f32x4 g = *(const f32x4*)(p.ln_g + l * 1024 + col), bb = *(const f32x4*)(p.ln_b + l * 1024 + col);
            const f32x4 ov = v[j] * rstd * g + bb;
            *(f32x4*)(p.out + (size_t)t * 1024 + col) = ov;
            if (l == 0) store4((bf16_t*)(ws + OFF_XB1) + (size_t)t * 1024 + col, ov); }
    }
}

#ifndef REP_PH
#define REP_PH 0
#endif
#ifndef PHMASK
#define PHMASK 0x1ff
#endif

#define XB_TMO      128
#define XB_XCNT(j)  (256  + 64 * (j))
#define XB_XSUB(j)  (1280 + 64 * (j))
#define XB_XGEN(j)  (2304 + 64 * (j))
#define XB_TOP      3328
#define XB_TOPGEN   3392
#define XCD_BAR_WORDS 3456
#define XB_SPIN_CAP (1u << 18)
#define LAS __attribute__((address_space(3)))
DEV unsigned xb_ld(unsigned* p)              { return __hip_atomic_load(p, __ATOMIC_RELAXED, __HIP_MEMORY_SCOPE_AGENT); }
DEV unsigned xb_add(unsigned* p, unsigned v) { return __hip_atomic_fetch_add(p, v, __ATOMIC_RELAXED, __HIP_MEMORY_SCOPE_AGENT); }
DEV unsigned xb_xcc_id() { return (unsigned)__builtin_amdgcn_s_getreg((3 << 11) | 20) & 0xFu; }
#define XB_SPIN(cond, bar) do { unsigned _sp = 0; while (cond) { __builtin_amdgcn_s_sleep(1); \
    if ((++_sp & 255u) == 0u) { if (xb_ld(&(bar)[XB_TMO])) break; if (_sp > XB_SPIN_CAP) { atomicAdd(&(bar)[XB_TMO], 1u); break; } } } } while (0)
struct XcdBarrier { unsigned* bar; unsigned x; volatile LAS unsigned* st; };
DEV XcdBarrier xcd_barrier_post(unsigned* bar, volatile LAS unsigned* st) {
    XcdBarrier b; b.bar = bar; b.x = xb_xcc_id(); b.st = st;
    if (threadIdx.x == 0) st[3] = xb_add(&bar[XB_XCNT(b.x)], 1u);
    return b;
}
DEV void xcd_barrier_complete(unsigned* bar, unsigned x, unsigned& nloc, unsigned& nx) {
    const unsigned G = gridDim.x * gridDim.y * gridDim.z;
    unsigned sum, cnt, mine, sp = 0u;
    for (;;) {
        sum = 0u; cnt = 0u; mine = 0u;
#pragma unroll
        for (unsigned j = 0; j < 16; ++j) { const unsigned c = xb_ld(&bar[XB_XCNT(j)]); sum += c; cnt += (c > 0u) ? 1u : 0u; mine = (j == x) ? c : mine; }
        if (sum == G) break;
        __builtin_amdgcn_s_sleep(1);
        if ((++sp & 255u) == 0u) { if (xb_ld(&bar[XB_TMO])) break; if (sp > XB_SPIN_CAP) { atomicAdd(&bar[XB_TMO], 1u); break; } }
    }
    nloc = mine > 0u ? mine : 1u; nx = cnt > 0u ? cnt : 1u;
}
DEV void xcd_barrier(const XcdBarrier& b) {
    asm volatile("s_waitcnt vmcnt(0)" ::: "memory");
    __syncthreads();
    if (threadIdx.x == 0) {
        unsigned* bar = b.bar;
        __builtin_amdgcn_s_waitcnt(0);
        unsigned nloc = b.st[0], nx = b.st[1];
        if (nloc == 0u) { xcd_barrier_complete(bar, b.x, nloc, nx); b.st[0] = nloc; b.st[1] = nx; }
        const unsigned old = xb_add(&bar[XB_XSUB(b.x)], 1u);
        const unsigned gen = old / nloc;
        if (old + 1u == (gen + 1u) * nloc) {
            __builtin_amdgcn_fence(__ATOMIC_RELEASE, "agent");
            asm volatile("s_waitcnt vmcnt(0)" ::: "memory");
            const unsigned og = xb_add(&bar[XB_TOP], 1u);
            const unsigned tg = og / nx;
            if (og + 1u == (tg + 1u) * nx) xb_add(&bar[XB_TOPGEN], 1u);
            else XB_SPIN(xb_ld(&bar[XB_TOPGEN]) == tg, bar);
            __builtin_amdgcn_fence(__ATOMIC_ACQUIRE, "agent");
            xb_add(&bar[XB_XGEN(b.x)], 1u);
            asm volatile("s_waitcnt vmcnt(0)" ::: "memory");
        } else {
            XB_SPIN(xb_ld(&bar[XB_XGEN(b.x)]) == gen, bar);
            __builtin_amdgcn_fence(__ATOMIC_ACQUIRE, "agent");
            asm volatile("s_waitcnt vmcnt(0)" ::: "memory");
        }
    }
    __syncthreads();
}
constexpr size_t OFF_BAR = ((WS_END + 4095) / 4096) * 4096;
#define GSYNC_CG() do { asm volatile("s_waitcnt vmcnt(0) lgkmcnt(0)" ::: "memory"); grid.sync(); } while (0)
#define GSYNC() xcd_barrier(xb)
typedef const __attribute__((address_space(4))) Params* KParams;
DEV Params load_params() {
#if defined(__HIP_DEVICE_COMPILE__)
    auto k = __builtin_amdgcn_kernarg_segment_ptr();
    asm volatile("" : "+s"(k) :: "memory");
    return *(KParams)k;
#else
    return Params{};
#endif
}
__global__ void __launch_bounds__(NTHR) mega_fwd(Params p_unused) {
    char* smem = smem_g;
    cg::grid_group grid = cg::this_grid();
    XcdBarrier xb;
    {
        volatile LAS unsigned* st = (volatile LAS unsigned*)(smem + LDS_MAIN);
        if (threadIdx.x == 0) { st[0] = 0u; st[1] = 0u; st[2] = blockIdx.x; st[3] = 0u; }
        __syncthreads();
        const Params p = load_params();
        xb = xcd_barrier_post((unsigned*)(p.ws + OFF_BAR), st);
    }
    if (PHMASK & 1) { const Params p = load_params(); phase_prologue(p, smem); }
    GSYNC_CG();
    {
        if (threadIdx.x == 0) {
            const unsigned G = gridDim.x; bool ok = (G % 8u) == 0u;
            for (unsigned j = 0; j < 16; ++j) { const unsigned c = xb_ld(&xb.bar[XB_XCNT(j)]); ok = ok && (c == (j < 8u ? G / 8u : 0u)); }
            if (ok) xb.st[2] = xb.st[3] * 8u + xb.x;
        }
        __syncthreads();
    }
    if (REP_PH == 9) { const Params p = load_params(); phase_prologue(p, smem); GSYNC(); }
    if (REP_PH == 10) { for (int q = 0; q < 20; ++q) GSYNC(); }
    for (int l = 0; l < 2; ++l) {
        if (PHMASK & 2) { const Params p = load_params(); phase1(p, l, smem); } GSYNC();
        if (REP_PH == 1) { const Params p = load_params(); int dry = 1; asm volatile("" : "+s"(dry)); phase1(p, l, smem); GSYNC(); }
        if (PHMASK & 4) { const Params p = load_params(); phase2(p, l, smem); } GSYNC();
        if (REP_PH == 2) { const Params p = load_params(); int dry = 1; asm volatile("" : "+s"(dry)); phase2(p, l, smem, dry); GSYNC(); }
        if (REP_PH >= 31 && REP_PH <= 34) { const Params p = load_params(); int dry = 1, parts = 1 << (REP_PH - 31); asm volatile("" : "+s"(dry), "+s"(parts)); phase2(p, l, smem, dry, parts); GSYNC(); }
        if (PHMASK & 8) { const Params p = load_params(); phase3(p, l, smem); } GSYNC();
        if (REP_PH == 3) { const Params p = load_params(); int dry = 1; asm volatile("" : "+s"(dry)); phase3(p, l, smem, dry); GSYNC(); }
        if (PHMASK & 16) { const Params p = load_params(); phase4(p, l, smem); } GSYNC();
        if (REP_PH == 4) { const Params p = load_params(); int dry = 1; asm volatile("" : "+s"(dry)); phase4(p, l, smem); GSYNC(); }
        if (PHMASK & 32) { const Params p = load_params(); phase5(p, smem); } GSYNC();
        if (REP_PH == 5) { const Params p = load_params(); int dry = 1; asm volatile("" : "+s"(dry)); phase5(p, smem, dry); GSYNC(); }
        if (PHMASK & 64) { const Params p = load_params(); phase6(p, l, smem); } GSYNC();
        if (REP_PH == 6) { const Params p = load_params(); int dry = 1; asm volatile("" : "+s"(dry)); phase6(p, l, smem); GSYNC(); }
        if (PHMASK & 128) { const Params p = load_params(); phase7(p, l, smem); } GSYNC();
        if (REP_PH == 7) { const Params p = load_params(); int dry = 1; asm volatile("" : "+s"(dry)); phase7(p, l, smem); GSYNC(); }
        if (PHMASK & 256) { const Params p = load_params(); phase8(p, l); }
        if (l == 0) GSYNC();
    }
}

extern "C" void kernel_launch(void* const* d_in, const int* in_sizes, int n_in, void* d_out, int out_size, void* d_ws, size_t ws_size, hipStream_t stream) {
    static int grid_blocks = 0;
    if (grid_blocks == 0) {
        if (n_in != 28 || ws_size < OFF_BAR + XCD_BAR_WORDS * 4) { fprintf(stderr, "kernel_launch: unexpected n_in %d or ws %zu (< %zu)\n", n_in, ws_size, (size_t)WS_END); grid_blocks = -1; return; }
        int dev = 0, cus = 0, per_cu = 0;
        hipGetDevice(&dev);
        hipDeviceGetAttribute(&cus, hipDeviceAttributeMultiprocessorCount, dev);
        if (hipFuncSetAttribute((const void*)mega_fwd, hipFuncAttributeMaxDynamicSharedMemorySize, LDS_BYTES) != hipSuccess) { fprintf(stderr, "hipFuncSetAttribute failed\n"); grid_blocks = -1; return; }
        hipOccupancyMaxActiveBlocksPerMultiprocessor(&per_cu, (const void*)mega_fwd, NTHR, LDS_BYTES);
        if (per_cu < 1) { fprintf(stderr, "occupancy query returned %d\n", per_cu); grid_blocks = -1; return; }
        grid_blocks = cus * 1;
    }
    if (grid_blocks < 0) return;
    Params p{};
    p.x = (const float*)d_in[0]; p.mem = (const float*)d_in[1]; p.pos = (const int*)d_in[2]; p.w_in = (const float*)d_in[3]; p.b_gate = (const float*)d_in[4];
    p.rwkv_mu = (const float*)d_in[5]; p.rwkv_w0 = (const float*)d_in[6]; p.rwkv_w2 = (const float*)d_in[7]; p.rwkv_a0 = (const float*)d_in[8]; p.rwkv_a2 = (const float*)d_in[9];
    p.rwkv_k_k = (const float*)d_in[10]; p.rwkv_k_a = (const float*)d_in[11]; p.rwkv_r_k = (const float*)d_in[12]; p.rwkv_lnx_g = (const float*)d_in[13]; p.rwkv_lnx_b = (const float*)d_in[14];
    p.mla_q_norm = (const float*)d_in[15]; p.mla_w_uq = (const float*)d_in[16]; p.mla_kv_norm = (const float*)d_in[17]; p.mla_w_ukv = (const float*)d_in[18];
    p.conv_w = (const float*)d_in[19]; p.conv_b = (const float*)d_in[20]; p.conv_ln_g = (const float*)d_in[21]; p.conv_ln_b = (const float*)d_in[22];
    p.xattn_w = (const float*)d_in[23]; p.w_o_branch = (const float*)d_in[24]; p.w_out = (const float*)d_in[25]; p.ln_g = (const float*)d_in[26]; p.ln_b = (const float*)d_in[27];
    p.out = (float*)d_out; p.ws = (char*)d_ws;
    if (hipMemsetAsync((char*)d_ws + OFF_BAR, 0, XCD_BAR_WORDS * 4, stream) != hipSuccess) { fprintf(stderr, "memset failed\n"); return; }
    void* args[] = {&p};
    hipError_t e = hipLaunchCooperativeKernel((const void*)mega_fwd, dim3(grid_blocks), dim3(NTHR), args, LDS_BYTES, stream);
    if (e != hipSuccess) fprintf(stderr, "cooperative launch failed: %s (grid %d)\n", hipGetErrorString(e), grid_blocks);
}
```

```cpp
#include <hip/hip_runtime.h>
#include <hip/hip_cooperative_groups.h>
#include <cstdio>
#include <cstdint>
#include <cmath>
namespace cg = cooperative_groups;

typedef unsigned short bf16_t;
typedef short bf16x8 __attribute__((ext_vector_type(8)));
typedef float f32x4 __attribute__((ext_vector_type(4)));
typedef float f32x2 __attribute__((ext_vector_type(2)));
typedef unsigned u32x4 __attribute__((ext_vector_type(4)));
typedef unsigned u32x2 __attribute__((ext_vector_type(2)));

#define DEV __device__ __forceinline__

constexpr int NTHR = 512;
constexpr int T_TOK = 65536;
constexpr int SEQ = 2048;
constexpr int DM = 1024;
constexpr int IN_COLS = 10016;
constexpr int NH = 6016;
constexpr int NHP = 6144;
constexpr int LDS_MAIN = 147456;
constexpr int LDS_BYTES = LDS_MAIN + 16;
constexpr int LDSK = 80;

constexpr size_t sz_WIN = (size_t)NHP * 1024 * 2, sz_WM = (size_t)4096 * 1024 * 2, sz_WKVX = (size_t)1024 * 1024 * 2;
constexpr size_t sz_WUQ = (size_t)768 * 384 * 2, sz_WUK = (size_t)512 * 256 * 2, sz_WO = (size_t)4 * 1024 * 512 * 2, sz_WOUT = (size_t)1024 * 1024 * 2;
constexpr size_t sz_LORA = (size_t)512 * 64 * 2;
constexpr size_t R_WIN = 0, R_WM = R_WIN + sz_WIN, R_WKVX = R_WM + sz_WM, R_WUQ = R_WKVX + sz_WKVX, R_WUK = R_WUQ + sz_WUQ, R_WUV = R_WUK + sz_WUK;
constexpr size_t R_WO = R_WUV + sz_WUK, R_WOUT = R_WO + sz_WO, R_W2 = R_WOUT + sz_WOUT, R_A2 = R_W2 + sz_LORA, SZ_LW = ((R_A2 + sz_LORA + 4095) / 4096) * 4096;
constexpr size_t OFF_L1W = 0;
constexpr size_t OFF_MEMB = OFF_L1W + SZ_LW;
constexpr size_t OFF_CS = OFF_MEMB + (size_t)8192 * 1024 * 2;
constexpr size_t OFF_XK = OFF_CS + (size_t)T_TOK * 32 * 4;
constexpr size_t OFF_XVT = OFF_XK + (size_t)8192 * 512 * 2;
constexpr size_t OFF_RQ = OFF_XVT + (size_t)8192 * 512 * 2;
constexpr size_t OFF_RKV = OFF_RQ + (size_t)T_TOK * 4;
constexpr size_t OFF_Y = ((OFF_RKV + (size_t)T_TOK * 4 + 4095) / 4096) * 4096;
constexpr size_t OFF_QL = OFF_Y + (size_t)T_TOK * 2048 * 2;
constexpr size_t OFF_KVL = OFF_QL + (size_t)T_TOK * 384 * 2;
constexpr size_t OFF_KPE = OFF_KVL + (size_t)T_TOK * 256 * 2;
constexpr size_t OFF_CU = OFF_KPE + (size_t)T_TOK * 32 * 2;
constexpr size_t OFF_XQ = OFF_CU + (size_t)T_TOK * 512 * 2;
constexpr size_t OFF_RWP = OFF_XQ + (size_t)T_TOK * 512 * 2;
constexpr size_t OFF_EA = OFF_RWP + (size_t)T_TOK * 1664 * 2;
constexpr size_t OFF_XB1 = OFF_EA + (size_t)T_TOK * 1024 * 2;
constexpr size_t OFF_L0W = OFF_XB1 + (size_t)T_TOK * 1024 * 2 - SZ_LW;
constexpr size_t WS_END = OFF_XB1 + (size_t)T_TOK * 1024 * 2;
#define WOFF(NAME, l) (((l) == 0 ? OFF_L0W : OFF_L1W) + R_##NAME)
constexpr size_t OFF_MG = OFF_CU;
constexpr size_t OFF_QB = OFF_RWP;
constexpr size_t OFF_KN = OFF_QB + (size_t)T_TOK * 768 * 2;
constexpr size_t OFF_VTM = OFF_KN + (size_t)T_TOK * 512 * 2;
constexpr size_t OFF_OUT = OFF_RWP;
static_assert(OFF_VTM + (size_t)T_TOK * 512 * 2 <= OFF_XB1, "alias overflow");
static_assert(WS_END <= ((size_t)1 << 30), "workspace overflow");

struct Params {
    const float* x; const float* mem; const int* pos; const float* w_in; const float* b_gate; const float* rwkv_mu; const float* rwkv_w0;
    const float* rwkv_w2; const float* rwkv_a0; const float* rwkv_a2; const float* rwkv_k_k; const float* rwkv_k_a; const float* rwkv_r_k;
    const float* rwkv_lnx_g; const float* rwkv_lnx_b; const float* mla_q_norm; const float* mla_w_uq; const float* mla_kv_norm; const float* mla_w_ukv;
    const float* conv_w; const float* conv_b; const float* conv_ln_g; const float* conv_ln_b; const float* xattn_w; const float* w_o_branch;
    const float* w_out; const float* ln_g; const float* ln_b;
    float* out; char* ws;
};

typedef __bf16 bf16x2_t __attribute__((ext_vector_type(2)));
DEV unsigned pk_bf16(float lo, float hi) { const bf16x2_t v = __builtin_convertvector((f32x2){lo, hi}, bf16x2_t); return __builtin_bit_cast(unsigned, v); }
DEV bf16_t f2bf(float f) { return (bf16_t)(pk_bf16(f, 0.f) & 0xffffu); }
DEV float bflo(unsigned u) { return __uint_as_float(u << 16); }
DEV float bfhi(unsigned u) { return __uint_as_float(u & 0xffff0000u); }
DEV float bf2f(bf16_t h) { return __uint_as_float(((unsigned)h) << 16); }
DEV int otid() { int t = threadIdx.x; asm volatile("" : "+v"(t)); return t; }
extern __shared__ __attribute__((aligned(16))) char smem_g[];
DEV int obid() { int t = __builtin_amdgcn_readfirstlane(*(volatile int*)(smem_g + 147456 + 8)); asm volatile("" : "+s"(t)); return t; }
DEV int onb() { int t = gridDim.x; asm volatile("" : "+s"(t)); return t; }
DEV float sigmoidf_(float v) { return __builtin_amdgcn_rcpf(1.0f + __expf(-v)); }
DEV float siluf_(float v) { return v * __builtin_amdgcn_rcpf(1.0f + __expf(-v)); }
#define DPPF(v, ctrl) __builtin_bit_cast(float, __builtin_amdgcn_update_dpp(0, __builtin_bit_cast(int, (v)), (ctrl), 0xF, 0xF, true))
DEV float reduce8_dpp(float v) { v += DPPF(v, 0xB1); v += DPPF(v, 0x4E); v += DPPF(v, 0x141); return v; }
DEV float wave_sum(float v) {
#pragma unroll
    for (int o = 32; o >= 1; o >>= 1) v += __shfl_xor(v, o);
    return v;
}

template <int MI> DEV void mma_ktile(f32x4 (&acc)[MI][4], const bf16_t* sA, const bf16_t* sB, int wr, int wc, int fr, int fq) {
#pragma unroll
    for (int ks = 0; ks < 2; ++ks) {
        bf16x8 af[MI], bfr[4];
#pragma unroll
        for (int mi = 0; mi < MI; ++mi) af[mi] = *(const bf16x8*)(sA + (wr * 16 * MI + mi * 16 + fr) * LDSK + ks * 32 + fq * 8);
#pragma unroll
        for (int ni = 0; ni < 4; ++ni) bfr[ni] = *(const bf16x8*)(sB + (wc * 64 + ni * 16 + fr) * LDSK + ks * 32 + fq * 8);
#pragma unroll
        for (int mi = 0; mi < MI; ++mi)
#pragma unroll
            for (int ni = 0; ni < 4; ++ni) acc[mi][ni] = __builtin_amdgcn_mfma_f32_16x16x32_bf16(bfr[ni], af[mi], acc[mi][ni], 0, 0, 0);
    }
}

DEV void stage_rc(int b, int& R, int& C) { const int st = b >> 10, sb = b & 1023, swz = sb ^ (((sb >> 9) & 1) << 5); R = (st >> 1) * 16 + (swz >> 6); C = (st & 1) * 32 + ((swz & 63) >> 1); }
DEV void glds16(const bf16_t* g, char* l) { __builtin_amdgcn_global_load_lds((const unsigned*)g, (__attribute__((address_space(3))) unsigned*)l, 16, 0, 0); }
template <int MI, int PIPE = 1, int SYNC = 1>
DEV void gemm_mainloop(f32x4 (&acc)[MI][4], const bf16_t* A, int lda, int m0, const bf16_t* Bt, int ldb, int n0, int K, char* smem, int rot = 0) {
    constexpr int NHA = MI / 2, STG = (NHA + 1) * 16384;
    const int tid = otid(), wid = tid >> 6, lane = tid & 63, wr = wid >> 1, wc = wid & 1, fr = lane & 15, fq = lane >> 4;
    int R0, C0, R1, C1; stage_rc(tid * 16, R0, C0); stage_rc(tid * 16 + 8192, R1, C1);
    const bf16_t* gA0 = A + (size_t)(m0 + R0) * lda + C0; const bf16_t* gA1 = A + (size_t)(m0 + R1) * lda + C1;
    const bf16_t* gB0 = Bt + (size_t)(n0 + R0) * ldb + C0; const bf16_t* gB1 = Bt + (size_t)(n0 + R1) * ldb + C1;
    char* l0 = smem + tid * 16;
    const int sw = (fr * 64 + fq * 16) ^ ((fr >> 3) << 5);
    const char* rdA = smem + (wr * MI) * 2048 + sw;
    const char* rdB = smem + NHA * 16384 + (wc * 4) * 2048 + sw;
    const int nk = K / 64;
#define STAGE(stg, kt) do { char* _l = l0 + (stg) * STG; int _k = (kt) + rot; _k = _k >= nk ? _k - nk : _k; _k *= 64; \
        _Pragma("unroll") for (int h = 0; h < NHA; ++h) { glds16(gA0 + (size_t)h * 128 * lda + _k, _l + h * 16384); glds16(gA1 + (size_t)h * 128 * lda + _k, _l + h * 16384 + 8192); } \
        glds16(gB0 + _k, _l + NHA * 16384); glds16(gB1 + _k, _l + NHA * 16384 + 8192); } while (0)
#define WAITV_TILE() do { if constexpr (MI == 4) asm volatile("s_waitcnt vmcnt(6)" ::: "memory"); else asm volatile("s_waitcnt vmcnt(4)" ::: "memory"); } while (0)
    if constexpr (SYNC) __syncthreads();
    STAGE(0, 0); STAGE(1, 1); STAGE(2, 2);
    if constexpr (MI == 4) asm volatile("s_waitcnt vmcnt(12)" ::: "memory"); else asm volatile("s_waitcnt vmcnt(8)" ::: "memory");
    __builtin_amdgcn_s_barrier();
    asm volatile("" ::: "memory");
    int stg = 0;
    for (int kt = 0; kt < nk; ++kt) {
        const char* pa = rdA + stg * STG; const char* pb = rdB + stg * STG;
        bf16x8 af[2][MI], bfr[2][4];
#pragma unroll
        for (int mi = 0; mi < MI; ++mi) af[0][mi] = *(const bf16x8*)(pa + mi * 2048);
#pragma unroll
        for (int ni = 0; ni < 4; ++ni) bfr[0][ni] = *(const bf16x8*)(pb + ni * 2048);
        if constexpr (PIPE) {
#pragma unroll
            for (int mi = 0; mi < MI; ++mi) af[1][mi] = *(const bf16x8*)(pa + mi * 2048 + 1024);
#pragma unroll
            for (int ni = 0; ni < 4; ++ni) bfr[1][ni] = *(const bf16x8*)(pb + ni * 2048 + 1024);
            __builtin_amdgcn_sched_barrier(0);
        }
        __builtin_amdgcn_s_setprio(1);
#pragma unroll
        for (int mi = 0; mi < MI; ++mi)
#pragma unroll
            for (int ni = 0; ni < 4; ++ni) acc[mi][ni] = __builtin_amdgcn_mfma_f32_16x16x32_bf16(bfr[0][ni], af[0][mi], acc[mi][ni], 0, 0, 0);
        if constexpr (!PIPE) {
#pragma unroll
            for (int mi = 0; mi < MI; ++mi) af[1][mi] = *(const bf16x8*)(pa + mi * 2048 + 1024);
#pragma unroll
            for (int ni = 0; ni < 4; ++ni) bfr[1][ni] = *(const bf16x8*)(pb + ni * 2048 + 1024);
        }
        __builtin_amdgcn_sched_barrier(0);
        if (kt + 2 < nk) WAITV_TILE(); else asm volatile("s_waitcnt vmcnt(0)" ::: "memory");
        asm volatile("s_waitcnt lgkmcnt(0)" ::: "memory");
        __builtin_amdgcn_s_barrier();
        asm volatile("" ::: "memory");
        if (kt + 3 < nk) STAGE(stg, kt + 3);
        __builtin_amdgcn_sched_barrier(0);
#pragma unroll
        for (int mi = 0; mi < MI; ++mi)
#pragma unroll
            for (int ni = 0; ni < 4; ++ni) acc[mi][ni] = __builtin_amdgcn_mfma_f32_16x16x32_bf16(bfr[1][ni], af[1][mi], acc[mi][ni], 0, 0, 0);
        __builtin_amdgcn_s_setprio(0);
        stg = stg == 2 ? 0 : stg + 1;
    }
#undef STAGE
#undef WAITV_TILE
}

DEV void gemm256(f32x4 (&acc)[4][8], const bf16_t* A, int lda, int m0, const bf16_t* Bt, int ldb, int n0, int K, char* smem, int rot = 0) {
    const int tid = otid(), wid = tid >> 6, lane = tid & 63, wr = wid >> 1, wc = wid & 1, fr = lane & 15, fq = lane >> 4;
    int R, C; { const int b = tid * 16, st = b >> 10, sb = b & 1023, swz = sb ^ (((sb >> 9) & 1) << 5); R = st * 16 + (swz >> 6); C = (swz & 63) >> 1; }
    const bf16_t* gA = A + (size_t)(m0 + R) * lda + C;
    const bf16_t* gB = Bt + (size_t)(n0 + R) * ldb + C;
    const size_t hA = (size_t)128 * lda, hB = (size_t)128 * ldb;
    char* l0 = smem + tid * 16;
    const int sw = (fr * 64 + fq * 16) ^ ((fr >> 3) << 5);
    const char* rdA = smem + (wr * 4) * 1024 + sw;
    const char* rdB = smem + 16384 + wc * 8192 + sw;
    const int nk = K / 32;
#define STAGE(stg, kt) do { char* _l = l0 + (stg) * 32768; int _k = (kt) + rot; _k = _k >= nk ? _k - nk : _k; _k *= 32; glds16(gA + _k, _l); glds16(gA + hA + _k, _l + 8192); glds16(gB + _k, _l + 16384); glds16(gB + hB + _k, _l + 24576); } while (0)
    __syncthreads();
    STAGE(0, 0); STAGE(1, 1); STAGE(2, 2); STAGE(3, 3);
    asm volatile("s_waitcnt vmcnt(12)" ::: "memory");
    __builtin_amdgcn_s_barrier();
    asm volatile("" ::: "memory");
    for (int kt = 0; kt < nk; ++kt) {
        const int stg = kt & 3;
        const char* pa = rdA + stg * 32768; const char* pb = rdB + stg * 32768;
        bf16x8 af[4], bfr[8];
#pragma unroll
        for (int mi = 0; mi < 4; ++mi) af[mi] = *(const bf16x8*)(pa + mi * 1024);
#pragma unroll
        for (int ni = 0; ni < 8; ++ni) bfr[ni] = *(const bf16x8*)(pb + ni * 1024);
        __builtin_amdgcn_sched_barrier(0);
        __builtin_amdgcn_s_setprio(1);
#pragma unroll
        for (int ni = 0; ni < 4; ++ni)
#pragma unroll
            for (int mi = 0; mi < 4; ++mi) acc[mi][ni] = __builtin_amdgcn_mfma_f32_16x16x32_bf16(bfr[ni], af[mi], acc[mi][ni], 0, 0, 0);
        __builtin_amdgcn_sched_barrier(0);
        if (kt + 3 < nk) asm volatile("s_waitcnt vmcnt(8)" ::: "memory");
        else if (kt + 2 < nk) asm volatile("s_waitcnt vmcnt(4)" ::: "memory");
        else asm volatile("s_waitcnt vmcnt(0)" ::: "memory");
        asm volatile("s_waitcnt lgkmcnt(0)" ::: "memory");
        __builtin_amdgcn_s_barrier();
        asm volatile("" ::: "memory");
        if (kt + 4 < nk) STAGE(stg, kt + 4);
        __builtin_amdgcn_sched_barrier(0);
#pragma unroll
        for (int ni = 4; ni < 8; ++ni)
#pragma unroll
            for (int mi = 0; mi < 4; ++mi) acc[mi][ni] = __builtin_amdgcn_mfma_f32_16x16x32_bf16(bfr[ni], af[mi], acc[mi][ni], 0, 0, 0);
        __builtin_amdgcn_s_setprio(0);
    }
#undef STAGE
}
DEV void zero_acc8(f32x4 (&acc)[4][8]) {
#pragma unroll
    for (int mi = 0; mi < 4; ++mi)
#pragma unroll
        for (int ni = 0; ni < 8; ++ni) acc[mi][ni] = (f32x4){0.f, 0.f, 0.f, 0.f};
}
template <int MI> DEV void zero_acc(f32x4 (&acc)[MI][4]) {
#pragma unroll
    for (int mi = 0; mi < MI; ++mi)
#pragma unroll
        for (int ni = 0; ni < 4; ++ni) acc[mi][ni] = (f32x4){0.f, 0.f, 0.f, 0.f};
}
DEV void store4(bf16_t* p, f32x4 v) { *(u32x2*)p = (u32x2){pk_bf16(v[0], v[1]), pk_bf16(v[2], v[3])}; }

#define WAVE_IDS const int tid = otid(), wid = tid >> 6, lane = tid & 63, wr = wid >> 1, wc = wid & 1, fr = lane & 15, fq = lane >> 4; (void)wid; (void)lane; (void)wr; (void)wc; (void)fr; (void)fq;

template <class Map>
DEV void cvt_transpose(const float* src, int ld, int K, int Ndst, bf16_t* dst, Map map, const float* kscale, char* smem) {
    float* t = (float*)smem;
    const int ntn = Ndst / 64, ntk = K / 64, tid = otid();
    for (int tile = obid(); tile < ntn * ntk; tile += onb()) {
        const int tn = tile % ntn, tk = tile / ntn;
        __syncthreads();
#pragma unroll
        for (int i = 0; i < 2; ++i) {
            const int e = tid + i * NTHR, kk = e >> 4, n4 = (e & 15) * 4; const int sc = map(tn * 64 + n4);
            f32x4 v = (f32x4){0.f, 0.f, 0.f, 0.f};
            if (sc >= 0) { v = *(const f32x4*)(src + (size_t)(tk * 64 + kk) * ld + sc); if (kscale) v *= kscale[tk * 64 + kk]; }
            t[(n4 + 0) * 65 + kk] = v[0]; t[(n4 + 1) * 65 + kk] = v[1]; t[(n4 + 2) * 65 + kk] = v[2]; t[(n4 + 3) * 65 + kk] = v[3];
        }
        __syncthreads();
        { const int nn = tid >> 3, k8 = (tid & 7) * 8; const float* r = t + nn * 65 + k8;
          *(u32x4*)(dst + (size_t)(tn * 64 + nn) * K + tk * 64 + k8) = (u32x4){pk_bf16(r[0], r[1]), pk_bf16(r[2], r[3]), pk_bf16(r[4], r[5]), pk_bf16(r[6], r[7])}; }
    }
}
DEV int map_h(int n) {
    if (n < 2816) return n;
    if (n < 3328) return n + 32;
    if (n < 4352) { const int j = n - 3328, tile = j >> 7, jj = j & 127, sub = jj >> 4, i = jj & 15; return 3360 + tile * 64 + (sub >> 1) * 16 + i + ((sub & 1) ? 512 : 0); }
    if (n < 5888) return n + 32;
    if (n < 5920) return 2816 + (n - 5888);
    return -1;
}
DEV void phase_prologue(const Params& p, char* smem) {
    char* ws = p.ws;
    for (int l = 0; l < 2; ++l) {
        cvt_transpose(p.w_in + (size_t)l * 1024 * IN_COLS, IN_COLS, 1024, NH, (bf16_t*)(ws + WOFF(WIN, l)), [](int n) { return map_h(n); }, nullptr, smem);
        cvt_transpose(p.w_in + (size_t)l * 1024 * IN_COLS, IN_COLS, 1024, 4096, (bf16_t*)(ws + WOFF(WM, l)), [](int n) { return 5920 + n; }, nullptr, smem);
        cvt_transpose(p.xattn_w + (size_t)l * 1024 * 1024, 1024, 1024, 1024, (bf16_t*)(ws + WOFF(WKVX, l)), [](int n) { return n; }, nullptr, smem);
        cvt_transpose(p.mla_w_uq + (size_t)l * 384 * 768, 768, 384, 768, (bf16_t*)(ws + WOFF(WUQ, l)), [](int n) { return n; }, p.mla_q_norm + l * 384, smem);
        cvt_transpose(p.mla_w_ukv + (size_t)l * 256 * 1024, 1024, 256, 512, (bf16_t*)(ws + WOFF(WUK, l)), [](int n) { return (n >> 6) * 128 + (n & 63); }, p.mla_kv_norm + l * 256, smem);
        cvt_transpose(p.mla_w_ukv + (size_t)l * 256 * 1024, 1024, 256, 512, (bf16_t*)(ws + WOFF(WUV, l)), [](int n) { return (n >> 6) * 128 + 64 + (n & 63); }, p.mla_kv_norm + l * 256, smem);
        for (int n = 0; n < 4; ++n)
            cvt_transpose(p.w_o_branch + ((size_t)l * 4 + n) * 512 * 1024, 1024, 512, 1024, (bf16_t*)(ws + WOFF(WO, l)) + (size_t)n * 1024 * 512, [](int c) { return c; }, nullptr, smem);
        cvt_transpose(p.w_out + (size_t)l * 1024 * 1024, 1024, 1024, 1024, (bf16_t*)(ws + WOFF(WOUT, l)), [](int n) { return n; }, nullptr, smem);
        cvt_transpose(p.rwkv_w2 + (size_t)l * 64 * 512, 512, 64, 512, (bf16_t*)(ws + WOFF(W2, l)), [](int n) { return n; }, nullptr, smem);
        cvt_transpose(p.rwkv_a2 + (size_t)l * 64 * 512, 512, 64, 512, (bf16_t*)(ws + WOFF(A2, l)), [](int n) { return n; }, nullptr, smem);
    }
    {
        const size_t n4 = (size_t)T_TOK * 1024 / 4; bf16_t* xb = (bf16_t*)p.out;
        for (size_t i = (size_t)obid() * NTHR + otid(); i < n4; i += (size_t)onb() * NTHR) { const f32x4 v = *(const f32x4*)(p.x + i * 4); store4(xb + i * 4, v); }
    }
    {
        const size_t n4 = (size_t)8192 * 1024 / 4; bf16_t* mb = (bf16_t*)(ws + OFF_MEMB);
        for (size_t i = (size_t)obid() * NTHR + otid(); i < n4; i += (size_t)onb() * NTHR) { const f32x4 v = *(const f32x4*)(p.mem + i * 4); store4(mb + i * 4, v); }
    }
    {
        float* cs = (float*)(ws + OFF_CS);
        for (size_t i = (size_t)obid() * NTHR + otid(); i < (size_t)T_TOK * 16; i += (size_t)onb() * NTHR) {
            const int t = (int)(i >> 4), j = (int)(i & 15);
            const float inv = (float)exp2(-(double)j * (13.287712379549449 / 16.0));
            const float ang = (float)p.pos[t] * inv;
            double rev = (double)ang * 0.15915494309189535; rev -= rint(rev);
            cs[(size_t)t * 32 + j] = __builtin_amdgcn_cosf((float)rev); cs[(size_t)t * 32 + 16 + j] = __builtin_amdgcn_sinf((float)rev);
        }
    }
}

DEV void bounce_put(char* reg, int mi, int ns, int fr, int fq, f32x4 v) { *(u32x2*)(reg + (mi * 16 + fr) * 272 + (ns * 16 + fq * 4) * 2) = (u32x2){pk_bf16(v[0], v[1]), pk_bf16(v[2], v[3])}; }
template <int NS> DEV void bounce_flush(const char* reg, bf16_t* dst, int ld, int lane) {
    constexpr int CH = NS * 2, RPP = 64 / CH;
    const int chunk = lane % CH, rsub = lane / CH;
    __builtin_amdgcn_sched_barrier(0);
#pragma unroll
    for (int ps = 0; ps < CH; ++ps) { const int row = ps * RPP + rsub; *(u32x4*)(dst + (size_t)row * ld + chunk * 8) = *(const u32x4*)(reg + row * 272 + chunk * 16);
        if ((ps & 3) == 3) __builtin_amdgcn_sched_barrier(0); }
}
DEV u32x2 pk4(f32x4 v) { return (u32x2){pk_bf16(v[0], v[1]), pk_bf16(v[2], v[3])}; }
DEV void epi_h(const Params& p, const f32x4 (&acc)[4][8], int m0, int n0g, int, int, int, int, char* smem) {
    const int tid_ = otid(), wid__ = tid_ >> 6, wr = wid__ >> 1, wc = wid__ & 1, fr = tid_ & 15, fq = (tid_ & 63) >> 4;
    char* ws = p.ws; const int n0 = n0g + wc * 128, ti = n0 >> 7;
    if (ti >= 47) return;
    bf16_t* dst = nullptr; int ld = 0, coff = 0, mode = 0;
    if (ti < 13) { dst = (bf16_t*)(ws + OFF_RWP); ld = 1664; coff = n0; }
    else if (ti < 17) { dst = (bf16_t*)(ws + OFF_Y); ld = 2048; coff = n0 - 1664; mode = 1; }
    else if (ti < 20) { dst = (bf16_t*)(ws + OFF_QL); ld = 384; coff = n0 - 2176; }
    else if (ti < 22) { dst = (bf16_t*)(ws + OFF_KVL); ld = 256; coff = n0 - 2560; }
    else if (ti < 26) { dst = (bf16_t*)(ws + OFF_Y); ld = 2048; coff = 512 + n0 - 2816; mode = 1; }
    else if (ti < 34) { dst = (bf16_t*)(ws + OFF_CU); ld = 512; coff = (ti - 26) * 64; mode = 2; }
    else if (ti < 38) { dst = (bf16_t*)(ws + OFF_Y); ld = 2048; coff = 1024 + n0 - 4352; mode = 1; }
    else if (ti < 42) { dst = (bf16_t*)(ws + OFF_XQ); ld = 512; coff = n0 - 4864; }
    else if (ti < 46) { dst = (bf16_t*)(ws + OFF_Y); ld = 2048; coff = 1536 + n0 - 5376; mode = 1; }
    else { dst = (bf16_t*)(ws + OFF_KPE); ld = 32; mode = 3; }
    const int mbase = m0 + wr * 64;
    const int lane_ = fq * 16 + fr; char* reg = smem + (wr * 2 + wc) * 17408;
    if (mode <= 1) {
#pragma unroll
        for (int mi = 0; mi < 4; ++mi)
#pragma unroll
            for (int ni = 0; ni < 8; ++ni) { f32x4 v = acc[mi][ni]; if (mode == 1) { v[0] = siluf_(v[0]); v[1] = siluf_(v[1]); v[2] = siluf_(v[2]); v[3] = siluf_(v[3]); } bounce_put(reg, mi, ni, fr, fq, v); }
        bounce_flush<8>(reg, dst + (size_t)mbase * ld + coff, ld, lane_);
    } else if (mode == 2) {
#pragma unroll
        for (int mi = 0; mi < 4; ++mi)
#pragma unroll
            for (int pp = 0; pp < 4; ++pp) { const f32x4 a = acc[mi][2 * pp], g = acc[mi][2 * pp + 1]; f32x4 v;
                v[0] = a[0] * sigmoidf_(g[0]); v[1] = a[1] * sigmoidf_(g[1]); v[2] = a[2] * sigmoidf_(g[2]); v[3] = a[3] * sigmoidf_(g[3]); bounce_put(reg, mi, pp, fr, fq, v); }
        bounce_flush<4>(reg, dst + (size_t)mbase * ld + coff, ld, lane_);
    } else {
        const float* cs = (const float*)(ws + OFF_CS);
#pragma unroll
        for (int mi = 0; mi < 4; ++mi) { const size_t row = mbase + mi * 16 + fr;
            const f32x4 c = *(const f32x4*)(cs + row * 32 + fq * 4), s = *(const f32x4*)(cs + row * 32 + 16 + fq * 4);
            const f32x4 x1 = acc[mi][0], x2 = acc[mi][1];
            store4(dst + row * 32 + fq * 4, x1 * c - x2 * s); store4(dst + row * 32 + 16 + fq * 4, x1 * s + x2 * c); }
    }
}
template <int MI> DEV void epi_plain(const f32x4 (&acc)[MI][4], bf16_t* dst, int ld, int m0, int n0, int, int, int, int) {
    const int tid_ = otid(), wid__ = tid_ >> 6, wr = wid__ >> 1, wc = wid__ & 1, fr = tid_ & 15, fq = (tid_ & 63) >> 4;
#pragma unroll
    for (int mi = 0; mi < MI; ++mi) { const size_t row = m0 + wr * 16 * MI + mi * 16 + fr;
#pragma unroll
        for (int ni = 0; ni < 4; ++ni) store4(dst + row * ld + n0 + wc * 64 + ni * 16 + fq * 4, acc[mi][ni]); }
}
DEV void epi_plain8(const f32x4 (&acc)[4][8], bf16_t* dst, int ld, int m0, int n0, int, int, int, int, char* smem) {
    const int tid_ = otid(), wid__ = tid_ >> 6, wr = wid__ >> 1, wc = wid__ & 1, fr = tid_ & 15, fq = (tid_ & 63) >> 4;
    char* reg = smem + (wr * 2 + wc) * 17408;
#pragma unroll
    for (int mi = 0; mi < 4; ++mi)
#pragma unroll
        for (int ni = 0; ni < 8; ++ni) bounce_put(reg, mi, ni, fr, fq, acc[mi][ni]);
    bounce_flush<8>(reg, dst + (size_t)(m0 + wr * 64) * ld + n0 + wc * 128, ld, fq * 16 + fr);
}
DEV void phase1(const Params& p, int l, char* smem) {
    WAVE_IDS
    char* ws = p.ws;
    const bf16_t* xb = l == 0 ? (const bf16_t*)p.out : (const bf16_t*)(ws + OFF_XB1);
    const bf16_t* win = (const bf16_t*)(ws + WOFF(WIN, l));
    const bf16_t* wkv = (const bf16_t*)(ws + WOFF(WKVX, l));
    const bf16_t* memb = (const bf16_t*)(ws + OFF_MEMB);
    const int nb = onb(), bid = obid();
    const int n_main = 256 * 24, n_items = n_main + 128;
    for (int it = bid; it < n_items; it += nb) {
        asm volatile("" ::: "memory");
        f32x4 acc[4][8]; zero_acc8(acc);
        if (it < n_main) {
            const int xcd = it & 7, w = it >> 3;
            const int g = w >> 5, within = w & 31, mtg = g / 6, ntg = g % 6;
            const int mt = xcd * 32 + mtg * 8 + (within >> 2), nt = ntg * 4 + (within & 3);
            gemm256(acc, xb, 1024, mt * 256, win, 1024, nt * 256, 1024, smem, ((within & 3) * 8 + (within >> 2)) & 31);
            epi_h(p, acc, mt * 256, nt * 256, wr, wc, fr, fq, smem);
        } else if (it < n_main + 64) {
            const int j = it - n_main, mt = j >> 1, nt = j & 1;
            gemm256(acc, memb, 1024, mt * 256, wkv, 1024, nt * 256, 1024, smem);
            epi_plain8(acc, (bf16_t*)(ws + OFF_XK), 512, mt * 256, nt * 256, wr, wc, fr, fq, smem);
        } else {
            const int j = it - n_main - 64, b = j >> 1, mt = j & 1;
            gemm256(acc, wkv + (size_t)512 * 1024, 1024, mt * 256, memb + (size_t)b * 256 * 1024, 1024, 0, 1024, smem);
            epi_plain8(acc, (bf16_t*)(ws + OFF_XVT) + (size_t)b * 512 * 256, 256, mt * 256, 0, wr, wc, fr, fq, smem);
        }
    }
}

template <int DQK, int DV, bool CAUSAL, int MIA>
DEV void attn_item(const bf16_t* Q, int ldq, const bf16_t* K1, int ldk1, int D1, const bf16_t* K2, int ldk2, const bf16_t* Vt, int ldvt,
                   int nkt, int q0, float scale_log2, bf16_t* Yp, int ldy, char* smem, int dry = 0) {
    constexpr int LDK = DQK + 16, LDV = 72, KCH = DQK / 8;
    constexpr int NKC = 64 * KCH / NTHR + ((64 * KCH) % NTHR ? 1 : 0), NVC = DV * 8 / NTHR;
    bf16_t* sK = (bf16_t*)smem;
    bf16_t* sV = sK + 64 * LDK;
    constexpr int STG = 64 * LDK + DV * LDV;
    const int tid = otid(), w = tid >> 6, lane = tid & 63, fr = lane & 15, fq = lane >> 4;
    bf16x8 qf[MIA][DQK / 32];
#pragma unroll
    for (int mi = 0; mi < MIA; ++mi)
#pragma unroll
        for (int ks = 0; ks < DQK / 32; ++ks) qf[mi][ks] = *(const bf16x8*)(Q + (size_t)(w * 16 * MIA + mi * 16 + fr) * ldq + ks * 32 + fq * 8);
    f32x4 o[MIA][DV / 16];
#pragma unroll
    for (int mi = 0; mi < MIA; ++mi)
#pragma unroll
        for (int di = 0; di < DV / 16; ++di) o[mi][di] = (f32x4){0.f, 0.f, 0.f, 0.f};
    float mrun[MIA], lrun[MIA];
#pragma unroll
    for (int mi = 0; mi < MIA; ++mi) { mrun[mi] = -1e30f; lrun[mi] = 0.f; }
    u32x4 kreg[NKC], vreg[NVC];
    auto gload = [&](int kt) {
#pragma unroll
        for (int i = 0; i < NKC; ++i) { const int c = tid + i * NTHR; if (c < 64 * KCH) { const int row = c / KCH, col = (c % KCH) * 8;
            kreg[i] = col < D1 ? *(const u32x4*)(K1 + (size_t)(kt * 64 + row) * ldk1 + col) : *(const u32x4*)(K2 + (size_t)(kt * 64 + row) * ldk2 + (col - D1)); } }
#pragma unroll
        for (int i = 0; i < NVC; ++i) { const int c = tid + i * NTHR, d = c >> 3, ch = c & 7; vreg[i] = *(const u32x4*)(Vt + (size_t)d * ldvt + kt * 64 + ch * 8); }
    };
    auto sstore = [&](int buf) {
#pragma unroll
        for (int i = 0; i < NKC; ++i) { const int c = tid + i * NTHR; if (c < 64 * KCH) { const int row = c / KCH, col = (c % KCH) * 8; *(u32x4*)(sK + buf * STG + row * LDK + col) = kreg[i]; } }
#pragma unroll
        for (int i = 0; i < NVC; ++i) { const int c = tid + i * NTHR, d = c >> 3, ch = c & 7; *(u32x4*)(sV + buf * STG + d * LDV + ch * 8) = vreg[i]; }
    };
    gload(0);
    __syncthreads();
    sstore(0);
    if (nkt > 1) gload(1);
    __syncthreads();
    for (int kt = 0; kt < nkt; ++kt) {
        const bf16_t* cK = sK + (kt & 1) * STG; const bf16_t* cV = sV + (kt & 1) * STG;
        if (!(CAUSAL && kt * 64 > q0 + w * 16 * MIA + 16 * MIA - 1)) {
        f32x4 s[MIA][4];
#pragma unroll
        for (int mi = 0; mi < MIA; ++mi)
#pragma unroll
            for (int ni = 0; ni < 4; ++ni) s[mi][ni] = (f32x4){0.f, 0.f, 0.f, 0.f};
#pragma unroll
        for (int ks = 0; ks < DQK / 32; ++ks)
#pragma unroll
            for (int ni = 0; ni < 4; ++ni) { const bf16x8 kf = *(const bf16x8*)(cK + (ni * 16 + fr) * LDK + ks * 32 + fq * 8);
#pragma unroll
                for (int mi = 0; mi < MIA; ++mi) s[mi][ni] = __builtin_amdgcn_mfma_f32_16x16x32_bf16(kf, qf[mi][ks], s[mi][ni], 0, 0, 0); }
        bf16x8 pf[MIA][2];
#pragma unroll
        for (int mi = 0; mi < MIA; ++mi) {
            float mx = -1e30f;
            if (CAUSAL && kt * 64 + 63 > q0 + w * 16 * MIA) {
                const int qabs = q0 + w * 16 * MIA + mi * 16 + fr;
#pragma unroll
                for (int ni = 0; ni < 4; ++ni)
#pragma unroll
                    for (int r = 0; r < 4; ++r) { const int kabs = kt * 64 + ni * 16 + fq * 4 + r; if (kabs > qabs) s[mi][ni][r] = -1e30f; }
            }
#pragma unroll
            for (int ni = 0; ni < 4; ++ni) mx = fmaxf(mx, fmaxf(fmaxf(s[mi][ni][0], s[mi][ni][1]), fmaxf(s[mi][ni][2], s[mi][ni][3])));
            mx = fmaxf(mx, __shfl_xor(mx, 16)); mx = fmaxf(mx, __shfl_xor(mx, 32));
            const float mnew = fmaxf(mrun[mi], mx);
            const float mc = mnew * scale_log2;
            float ps = 0.f;
#pragma unroll
            for (int ni = 0; ni < 4; ++ni)
#pragma unroll
                for (int r = 0; r < 4; ++r) { const float pv = __builtin_amdgcn_exp2f(__builtin_fmaf(s[mi][ni][r], scale_log2, -mc)); s[mi][ni][r] = pv; ps += pv; }
            if (__builtin_amdgcn_ballot_w64(mnew > mrun[mi]) != 0ull) {
                const float alpha = __builtin_amdgcn_exp2f((mrun[mi] - mnew) * scale_log2);
                lrun[mi] *= alpha;
#pragma unroll
                for (int di = 0; di < DV / 16; ++di) o[mi][di] *= alpha;
            }
            mrun[mi] = mnew;
            lrun[mi] += ps;
#pragma unroll
            for (int s2 = 0; s2 < 2; ++s2) { const f32x4 a = s[mi][2 * s2], b = s[mi][2 * s2 + 1];
                const u32x4 pk = (u32x4){pk_bf16(a[0], a[1]), pk_bf16(a[2], a[3]), pk_bf16(b[0], b[1]), pk_bf16(b[2], b[3])};
                pf[mi][s2] = __builtin_bit_cast(bf16x8, pk); }
        }
#pragma unroll
        for (int di = 0; di < DV / 16; ++di)
#pragma unroll
            for (int s2 = 0; s2 < 2; ++s2) {
                const u32x2 v0 = *(const u32x2*)(cV + (di * 16 + fr) * LDV + s2 * 32 + fq * 4), v1 = *(const u32x2*)(cV + (di * 16 + fr) * LDV + s2 * 32 + 16 + fq * 4);
                const bf16x8 vf = __builtin_bit_cast(bf16x8, ((u32x4){v0[0], v0[1], v1[0], v1[1]}));
#pragma unroll
                for (int mi = 0; mi < MIA; ++mi) o[mi][di] = __builtin_amdgcn_mfma_f32_16x16x32_bf16(vf, pf[mi][s2], o[mi][di], 0, 0, 0);
            }
        }
        if (kt + 1 < nkt) { sstore((kt + 1) & 1); if (kt + 2 < nkt) gload(kt + 2); }
        __syncthreads();
    }
#pragma unroll
    for (int mi = 0; mi < MIA; ++mi) {
        float lt = lrun[mi]; lt += __shfl_xor(lt, 16); lt += __shfl_xor(lt, 32);
        const float inv = __builtin_amdgcn_rcpf(lt);
        bf16_t* yrow = Yp + (size_t)(w * 16 * MIA + mi * 16 + fr) * ldy;
#pragma unroll
        for (int di = 0; di < DV / 16; ++di) { bf16_t* yp = yrow + di * 16 + fq * 4; const u32x2 g = *(const u32x2*)yp;
            f32x4 v = o[mi][di] * inv; v[0] *= bflo(g[0]); v[1] *= bfhi(g[0]); v[2] *= bflo(g[1]); v[3] *= bfhi(g[1]); if (!dry) store4(yp, v); }
    }
}

DEV void lora_item(const Params& p, int l, int mt, int which, char* smem) {
    WAVE_IDS
    char* ws = p.ws;
    bf16_t* sA = (bf16_t*)smem; bf16_t* sB = sA + 256 * LDSK;
    const bf16_t* rwp = (const bf16_t*)(ws + OFF_RWP);
    const bf16_t* wt = (const bf16_t*)(ws + (which ? WOFF(A2, l) : WOFF(W2, l)));
    const int colb = 1536 + which * 64;
    const float* mu = p.rwkv_mu + l * 1664 + colb;
    const float* bias = (which ? p.rwkv_a0 : p.rwkv_w0) + l * 512;
    bf16_t* ea = (bf16_t*)(ws + OFF_EA) + which * 512;
    __syncthreads();
    const int crow = tid >> 3, cch = tid & 7;
    u32x4 breg[8];
#pragma unroll
    for (int i = 0; i < 8; ++i) breg[i] = *(const u32x4*)(wt + (size_t)(crow + i * 64) * 64 + cch * 8);
#pragma unroll
    for (int i = 0; i < 4; ++i) {
        const int row = crow + i * 64; const size_t t = (size_t)mt * 256 + row;
        const u32x4 cur = *(const u32x4*)(rwp + t * 1664 + colb + cch * 8);
        u32x4 prv = (u32x4){0u, 0u, 0u, 0u};
        if ((t & (SEQ - 1)) != 0) prv = *(const u32x4*)(rwp + (t - 1) * 1664 + colb + cch * 8);
        float v[8];
#pragma unroll
        for (int j = 0; j < 4; ++j) { const float c0 = bflo(cur[j]), c1 = bfhi(cur[j]), p0 = bflo(prv[j]), p1 = bfhi(prv[j]);
            v[2 * j] = c0 + mu[cch * 8 + 2 * j] * (p0 - c0); v[2 * j + 1] = c1 + mu[cch * 8 + 2 * j + 1] * (p1 - c1); }
        if (which == 0) {
#pragma unroll
            for (int j = 0; j < 8; ++j) { const float e2 = __expf(2.0f * v[j]); v[j] = 1.0f - 2.0f * __builtin_amdgcn_rcpf(e2 + 1.0f); }
        }
        *(u32x4*)(sA + row * LDSK + cch * 8) = (u32x4){pk_bf16(v[0], v[1]), pk_bf16(v[2], v[3]), pk_bf16(v[4], v[5]), pk_bf16(v[6], v[7])};
    }
#pragma unroll
    for (int i = 0; i < 8; ++i) *(u32x4*)(sB + (crow + i * 64) * LDSK + cch * 8) = breg[i];
    __syncthreads();
    for (int nt = 0; nt < 4; ++nt) {
        f32x4 acc[4][4]; zero_acc<4>(acc);
        mma_ktile<4>(acc, sA, sB + nt * 128 * LDSK, wr, wc, fr, fq);
#pragma unroll
        for (int mi = 0; mi < 4; ++mi) { const size_t row = (size_t)mt * 256 + wr * 64 + mi * 16 + fr;
#pragma unroll
            for (int ni = 0; ni < 4; ++ni) { const int col = nt * 128 + wc * 64 + ni * 16 + fq * 4; const f32x4 bz = *(const f32x4*)(bias + col); f32x4 v = acc[mi][ni] + bz;
#pragma unroll
                for (int r = 0; r < 4; ++r) { const float sg = sigmoidf_(v[r]); v[r] = which ? sg : 0.6065306597f * sg; }
                store4(ea + row * 1024 + col, v); } }
    }
}
DEV void conv_item(const Params& p, int l, int tile, char* smem, int dry) {
    char* ws = p.ws;
    bf16_t* sin_ = (bf16_t*)smem;
    float* sout = (float*)(smem + 62 * 1024);
    const bf16_t* cu = (const bf16_t*)(ws + OFF_CU);
    bf16_t* Y = (bf16_t*)(ws + OFF_Y);
    const int tid = otid(), wid = tid >> 6, lane = tid & 63;
    const int t0 = tile * 32, s0 = t0 & (SEQ - 1);
    __syncthreads();
    for (int c = tid; c < 62 * 64; c += NTHR) { const int row = c >> 6, ch = c & 63; const int srel = s0 - 30 + row;
        u32x4 v = (u32x4){0u, 0u, 0u, 0u};
        if (srel >= 0) v = *(const u32x4*)(cu + (size_t)(t0 - 30 + row) * 512 + ch * 8);
        *(u32x4*)(sin_ + row * 512 + ch * 8) = v; }
    float w[31];
#pragma unroll
    for (int j = 0; j < 31; ++j) w[j] = p.conv_w[((size_t)l * 31 + j) * 512 + tid];
    const float cb = p.conv_b[l * 512 + tid];
    __syncthreads();
    {
        float acc[32];
#pragma unroll
        for (int t = 0; t < 32; ++t) acc[t] = cb;
#pragma unroll
        for (int r = 0; r < 62; ++r) {
            const float xv = bf2f(sin_[r * 512 + tid]);
#pragma unroll
            for (int t = 0; t < 32; ++t) if (r - t >= 0 && r - t <= 30) acc[t] += w[r - t] * xv;
        }
#pragma unroll
        for (int t = 0; t < 32; ++t) sout[t * 512 + tid] = acc[t];
    }
    __syncthreads();
    const f32x4 g0 = *(const f32x4*)(p.conv_ln_g + l * 512 + lane * 8), g1 = *(const f32x4*)(p.conv_ln_g + l * 512 + lane * 8 + 4);
    const f32x4 b0 = *(const f32x4*)(p.conv_ln_b + l * 512 + lane * 8), b1 = *(const f32x4*)(p.conv_ln_b + l * 512 + lane * 8 + 4);
#pragma unroll 1
    for (int t = wid; t < 32; t += 8) {
        const f32x4 x0 = *(const f32x4*)(sout + t * 512 + lane * 8), x1 = *(const f32x4*)(sout + t * 512 + lane * 8 + 4);
        float sm = (x0[0] + x0[1]) + (x0[2] + x0[3]) + (x1[0] + x1[1]) + (x1[2] + x1[3]);
        const float mean = wave_sum(sm) * (1.0f / 512.0f);
        const f32x4 d0 = x0 - mean, d1 = x1 - mean;
        float sq = (d0[0] * d0[0] + d0[1] * d0[1]) + (d0[2] * d0[2] + d0[3] * d0[3]) + (d1[0] * d1[0] + d1[1] * d1[1]) + (d1[2] * d1[2] + d1[3] * d1[3]);
        const float rstd = rsqrtf(wave_sum(sq) * (1.0f / 512.0f) + 1e-5f);
        bf16_t* yp = Y + (size_t)(t0 + t) * 2048 + 1024 + lane * 8;
        const u32x4 g = *(const u32x4*)yp;
        f32x4 y0 = d0 * rstd * g0 + b0, y1 = d1 * rstd * g1 + b1;
        float o[8];
#pragma unroll
        for (int j = 0; j < 4; ++j) { o[j] = siluf_(y0[j]); o[4 + j] = siluf_(y1[j]); }
#pragma unroll
        for (int j = 0; j < 4; ++j) { o[2 * j] *= bflo(g[j]); o[2 * j + 1] *= bfhi(g[j]); }
        if (!dry) *(u32x4*)yp = (u32x4){pk_bf16(o[0], o[1]), pk_bf16(o[2], o[3]), pk_bf16(o[4], o[5]), pk_bf16(o[6], o[7])};
    }
}
DEV void phase2(const Params& p, int l, char* smem, int dry = 0, int parts = 15) {
    char* ws = p.ws;
    const int nb = onb(), bid = obid();
    if (parts & 1) for (int it = bid; it < 512; it += nb) { asm volatile("" ::: "memory"); lora_item(p, l, it >> 1, it & 1, smem); }
    if (parts & 2) for (int j = bid; j < 2048; j += nb) {
        asm volatile("" ::: "memory");
        const int qb = j & 15, h = (j >> 4) & 3, b = j >> 6;
        const size_t t0 = (size_t)b * SEQ + qb * 128;
        attn_item<128, 128, false, 1>((const bf16_t*)(ws + OFF_XQ) + t0 * 512 + h * 128, 512,
                                      (const bf16_t*)(ws + OFF_XK) + (size_t)b * 256 * 512 + h * 128, 512, 128, nullptr, 0,
                                      (const bf16_t*)(ws + OFF_XVT) + ((size_t)b * 512 + h * 128) * 256, 256,
                                      4, 0, 0.08838834764831845f * 1.4426950408889634f, (bf16_t*)(ws + OFF_Y) + t0 * 2048 + 1536 + h * 128, 2048, smem, dry);
    }
    if (parts & 4) for (int it = bid; it < 2048; it += nb) { asm volatile("" ::: "memory"); conv_item(p, l, it, smem, dry); }
    if (!(parts & 8)) return;
    const int wid = otid() >> 6, lane = otid() & 63, li = lane & 15, tg = lane >> 4;
    const bf16_t* ql = (const bf16_t*)(ws + OFF_QL); const bf16_t* kvl = (const bf16_t*)(ws + OFF_KVL);
    float* rq = (float*)(ws + OFF_RQ); float* rkv = (float*)(ws + OFF_RKV);
    auto sq8 = [](u32x4 u) { float s = 0.f;
#pragma unroll
        for (int j = 0; j < 4; ++j) { const float a = bflo(u[j]), b = bfhi(u[j]); s += a * a + b * b; } return s; };
#pragma unroll 2
    for (int t = (bid * 8 + wid) * 4 + tg; t < T_TOK; t += nb * 32) {
        const u32x4* qp = (const u32x4*)(ql + (size_t)t * 384); const u32x4* kp = (const u32x4*)(kvl + (size_t)t * 256);
        const u32x4 q0 = qp[li], q1 = qp[li + 16], q2 = qp[li + 32], k0 = kp[li], k1 = kp[li + 16];
        float s = sq8(q0) + sq8(q1) + sq8(q2), s2 = sq8(k0) + sq8(k1);
        s += DPPF(s, 0xB1); s += DPPF(s, 0x4E); s += DPPF(s, 0x141); s += DPPF(s, 0x140);
        s2 += DPPF(s2, 0xB1); s2 += DPPF(s2, 0x4E); s2 += DPPF(s2, 0x141); s2 += DPPF(s2, 0x140);
        if (li == 0) { rq[t] = rsqrtf(s * (1.0f / 384.0f) + 1e-6f); rkv[t] = rsqrtf(s2 * (1.0f / 256.0f) + 1e-6f); }
    }
}

DEV void phase3(const Params& p, int l, char* smem, int dry = 0) {
    char* ws = p.ws;
    float* op = (float*)smem;
    float* ybuf = op + 2 * 32 * 384;
    float* bon = ybuf + 2 * 32 * 64;
    const bf16_t* rwp = (const bf16_t*)(ws + OFF_RWP);
    const bf16_t* ea = (const bf16_t*)(ws + OFF_EA);
    bf16_t* Y = (bf16_t*)(ws + OFF_Y);
    const int tid = otid();
    for (int chain = obid(); chain < 256; chain += onb()) {
        asm volatile("" ::: "memory");
        const int b = chain >> 3, h = chain & 7;
        __syncthreads();
        if (__builtin_amdgcn_readfirstlane(tid) >= 256) {
            const int pt = tid - 256, tok = pt >> 3, g = pt & 7, c0 = h * 64 + g * 8;
            float mur[8], muk[8], muv[8], kk_[8], ka_[8], rk_[8], lg[8], lb[8];
#pragma unroll
            for (int j = 0; j < 8; ++j) {
                mur[j] = p.rwkv_mu[l * 1664 + c0 + j]; muk[j] = p.rwkv_mu[l * 1664 + 512 + c0 + j]; muv[j] = p.rwkv_mu[l * 1664 + 1024 + c0 + j];
                kk_[j] = p.rwkv_k_k[l * 512 + c0 + j]; ka_[j] = p.rwkv_k_a[l * 512 + c0 + j]; rk_[j] = p.rwkv_r_k[l * 512 + c0 + j];
                lg[j] = p.rwkv_lnx_g[l * 512 + c0 + j]; lb[j] = p.rwkv_lnx_b[l * 512 + c0 + j];
            }
            auto prep = [&](int ci) {
                const int buf = ci & 1, s = ci * 32 + tok; const size_t t = (size_t)b * SEQ + s;
                const bf16_t* row = rwp + t * 1664 + c0;
                const u32x4 rc = *(const u32x4*)row, kc = *(const u32x4*)(row + 512), vc = *(const u32x4*)(row + 1024);
                u32x4 rp = (u32x4){0u, 0u, 0u, 0u}, kp = rp, vp = rp;
                if (s > 0) { rp = *(const u32x4*)(row - 1664); kp = *(const u32x4*)(row - 1664 + 512); vp = *(const u32x4*)(row - 1664 + 1024); }
                const u32x4 ee = *(const u32x4*)(ea + t * 1024 + c0), aa = *(const u32x4*)(ea + t * 1024 + 512 + c0);
                float r[8], k[8], v[8], kk[8], e[8], a[8];
#pragma unroll
                for (int j = 0; j < 4; ++j) {
                    float c, q;
                    c = bflo(rc[j]); q = bflo(rp[j]); r[2 * j] = c + mur[2 * j] * (q - c); c = bfhi(rc[j]); q = bfhi(rp[j]); r[2 * j + 1] = c + mur[2 * j + 1] * (q - c);
                    c = bflo(kc[j]); q = bflo(kp[j]); k[2 * j] = c + muk[2 * j] * (q - c); c = bfhi(kc[j]); q = bfhi(kp[j]); k[2 * j + 1] = c + muk[2 * j + 1] * (q - c);
                    c = bflo(vc[j]); q = bflo(vp[j]); v[2 * j] = c + muv[2 * j] * (q - c); c = bfhi(vc[j]); q = bfhi(vp[j]); v[2 * j + 1] = c + muv[2 * j + 1] * (q - c);
                    e[2 * j] = bflo(ee[j]); e[2 * j + 1] = bfhi(ee[j]); a[2 * j] = bflo(aa[j]); a[2 * j + 1] = bfhi(aa[j]);
                }
                float ss = 0.f;
#pragma unroll
                for (int j = 0; j < 8; ++j) { kk[j] = k[j] * kk_[j]; ss += kk[j] * kk[j]; }
                ss += __shfl_xor(ss, 1); ss += __shfl_xor(ss, 2); ss += __shfl_xor(ss, 4);
                const float inv = 1.0f / fmaxf(sqrtf(ss), 1e-12f);
                float* o = op + (size_t)(buf * 32 + tok) * 384 + g * 8;
                float bs = 0.f;
#pragma unroll
                for (int j = 0; j < 8; ++j) {
                    const float kn = kk[j] * inv, km = k[j] * (1.0f + (a[j] - 1.0f) * ka_[j]);
                    o[j] = -kn; o[64 + j] = __expf(-e[j]); o[128 + j] = kn * a[j]; o[192 + j] = km; o[256 + j] = r[j]; o[320 + j] = v[j];
                    bs += r[j] * km * rk_[j];
                }
                bs += __shfl_xor(bs, 1); bs += __shfl_xor(bs, 2); bs += __shfl_xor(bs, 4);
                if (g == 0) bon[buf * 32 + tok] = bs;
            };
            auto post = [&](int ci) {
                const int buf = ci & 1, s = ci * 32 + tok; const size_t t = (size_t)b * SEQ + s;
                const float* yb = ybuf + (buf * 32 + tok) * 64 + g * 8;
                float y[8]; float sm = 0.f;
#pragma unroll
                for (int j = 0; j < 8; ++j) { y[j] = yb[j]; sm += y[j]; }
                sm += __shfl_xor(sm, 1); sm += __shfl_xor(sm, 2); sm += __shfl_xor(sm, 4);
                const float mean = sm * (1.0f / 64.0f); float sq = 0.f;
#pragma unroll
                for (int j = 0; j < 8; ++j) { y[j] -= mean; sq += y[j] * y[j]; }
                sq += __shfl_xor(sq, 1); sq += __shfl_xor(sq, 2); sq += __shfl_xor(sq, 4);
                const float rstd = rsqrtf(sq * (1.0f / 64.0f) + 64e-5f);
                const float bo = bon[buf * 32 + tok];
                const float* vv = op + (size_t)(buf * 32 + tok) * 384 + 320 + g * 8;
                bf16_t* yp = Y + t * 2048 + c0;
                const u32x4 gg = *(const u32x4*)yp;
                float o[8];
#pragma unroll
                for (int j = 0; j < 8; ++j) o[j] = y[j] * rstd * lg[j] + lb[j] + bo * vv[j];
#pragma unroll
                for (int j = 0; j < 4; ++j) { o[2 * j] *= bflo(gg[j]); o[2 * j + 1] *= bfhi(gg[j]); }
                if (!dry) *(u32x4*)yp = (u32x4){pk_bf16(o[0], o[1]), pk_bf16(o[2], o[3]), pk_bf16(o[4], o[5]), pk_bf16(o[6], o[7])};
            };
            prep(0);
            __syncthreads();
            for (int ci = 0; ci < 64; ++ci) {
                if (ci >= 1) post(ci - 1);
                if (ci + 1 < 64) prep(ci + 1);
                __syncthreads();
            }
            post(63);
        } else {
            const int vp = tid >> 3, kq = tid & 7;
            f32x2 st[2][4];
#pragma unroll
            for (int i = 0; i < 2; ++i)
#pragma unroll
                for (int j = 0; j < 4; ++j) st[i][j] = (f32x2){0.f, 0.f};
            __syncthreads();
            for (int ci = 0; ci < 64; ++ci) {
                const int buf = ci & 1;
                const float* base0 = op + (size_t)buf * 32 * 384 + kq * 8;
                float* yb = ybuf + buf * 32 * 64 + 2 * vp;
#pragma unroll 4
                for (int tok = 0; tok < 32; ++tok) {
                    const float* bs = base0 + tok * 384;
                    const f32x4 a0 = *(const f32x4*)bs, a1 = *(const f32x4*)(bs + 4);
                    const f32x4 w0 = *(const f32x4*)(bs + 64), w1 = *(const f32x4*)(bs + 68);
                    const f32x4 b0 = *(const f32x4*)(bs + 128), b1 = *(const f32x4*)(bs + 132);
                    const f32x4 k0 = *(const f32x4*)(bs + 192), k1 = *(const f32x4*)(bs + 196);
                    const f32x4 r0 = *(const f32x4*)(bs + 256), r1 = *(const f32x4*)(bs + 260);
                    const f32x2 vv = *(const f32x2*)(op + (size_t)(buf * 32 + tok) * 384 + 320 + 2 * vp);
                    const f32x2 av[4] = {(f32x2){a0[0], a0[1]}, (f32x2){a0[2], a0[3]}, (f32x2){a1[0], a1[1]}, (f32x2){a1[2], a1[3]}};
                    const f32x2 wv[4] = {(f32x2){w0[0], w0[1]}, (f32x2){w0[2], w0[3]}, (f32x2){w1[0], w1[1]}, (f32x2){w1[2], w1[3]}};
                    const f32x2 bv[4] = {(f32x2){b0[0], b0[1]}, (f32x2){b0[2], b0[3]}, (f32x2){b1[0], b1[1]}, (f32x2){b1[2], b1[3]}};
                    const f32x2 kv[4] = {(f32x2){k0[0], k0[1]}, (f32x2){k0[2], k0[3]}, (f32x2){k1[0], k1[1]}, (f32x2){k1[2], k1[3]}};
                    const f32x2 rv[4] = {(f32x2){r0[0], r0[1]}, (f32x2){r0[2], r0[3]}, (f32x2){r1[0], r1[1]}, (f32x2){r1[2], r1[3]}};
                    float yo[2];
#pragma unroll
                    for (int i = 0; i < 2; ++i) {
                        f32x2 sa2 = st[i][0] * av[0]; sa2 += st[i][1] * av[1]; sa2 += st[i][2] * av[2]; sa2 += st[i][3] * av[3];
                        const float sa = reduce8_dpp(sa2[0] + sa2[1]);
                        const float vi = vv[i];
                        f32x2 y2 = (f32x2){0.f, 0.f};
#pragma unroll
                        for (int j = 0; j < 4; ++j) { st[i][j] = st[i][j] * wv[j] + sa * bv[j] + vi * kv[j]; y2 += st[i][j] * rv[j]; }
                        yo[i] = reduce8_dpp(y2[0] + y2[1]);
                    }
                    if (kq == 0) *(f32x2*)(yb + tok * 64) = (f32x2){yo[0], yo[1]};
                }
                __syncthreads();
            }
        }
    }
}

DEV void phase4(const Params& p, int l, char* smem) {
    WAVE_IDS
    char* ws = p.ws;
    const bf16_t* ql = (const bf16_t*)(ws + OFF_QL); const bf16_t* kvl = (const bf16_t*)(ws + OFF_KVL);
    const float* rq = (const float*)(ws + OFF_RQ); const float* rkv = (const float*)(ws + OFF_RKV);
    const float* cs = (const float*)(ws + OFF_CS);
    bf16_t* qb = (bf16_t*)(ws + OFF_QB); bf16_t* kn = (bf16_t*)(ws + OFF_KN); bf16_t* vtm = (bf16_t*)(ws + OFF_VTM);
    const bf16_t* wuq = (const bf16_t*)(ws + WOFF(WUQ, l)); const bf16_t* wuk = (const bf16_t*)(ws + WOFF(WUK, l)); const bf16_t* wuv = (const bf16_t*)(ws + WOFF(WUV, l));
    const int n_items = 768 + 512 + 512;
    for (int it = obid(); it < n_items; it += onb()) {
        asm volatile("" ::: "memory");
        f32x4 acc[4][8]; zero_acc8(acc);
        if (it < 768) {
            const int mt = it / 3, nt = it % 3, m0 = mt * 256, n0 = nt * 256 + wc * 128;
            gemm256(acc, ql, 384, m0, wuq, 384, nt * 256, 384, smem);
#pragma unroll
            for (int mi = 0; mi < 4; ++mi) { const size_t row = m0 + wr * 64 + mi * 16 + fr; const float rs = rq[row];
                const f32x4 c = *(const f32x4*)(cs + row * 32 + fq * 4), s = *(const f32x4*)(cs + row * 32 + 16 + fq * 4);
#pragma unroll
                for (int ni = 0; ni < 8; ++ni) acc[mi][ni] *= rs;
#pragma unroll
                for (int pp = 0; pp < 4; ++pp) { const int cs0 = n0 + pp * 32; if ((cs0 % 96) == 64) { const f32x4 x1 = acc[mi][2 * pp], x2 = acc[mi][2 * pp + 1]; acc[mi][2 * pp] = x1 * c - x2 * s; acc[mi][2 * pp + 1] = x1 * s + x2 * c; } }
#pragma unroll
                for (int ni = 0; ni < 8; ++ni) store4(qb + row * 768 + n0 + ni * 16 + fq * 4, acc[mi][ni]); }
        } else if (it < 1280) {
            const int j = it - 768, mt = j >> 1, nt = j & 1, m0 = mt * 256, n0 = nt * 256 + wc * 128;
            gemm256(acc, kvl, 256, m0, wuk, 256, nt * 256, 256, smem);
#pragma unroll
            for (int mi = 0; mi < 4; ++mi) { const size_t row = m0 + wr * 64 + mi * 16 + fr; const float rs = rkv[row];
#pragma unroll
                for (int ni = 0; ni < 8; ++ni) store4(kn + row * 512 + n0 + ni * 16 + fq * 4, acc[mi][ni] * rs); }
        } else {
            const int j = it - 1280, b = j >> 4, mt = (j >> 3) & 1, nt = j & 7, m0 = mt * 256, n0 = nt * 256 + wc * 128;
            gemm256(acc, wuv, 256, m0, kvl + (size_t)b * SEQ * 256, 256, nt * 256, 256, smem);
#pragma unroll
            for (int ni = 0; ni < 8; ++ni) { const int col = n0 + ni * 16 + fq * 4; const f32x4 rs = *(const f32x4*)(rkv + (size_t)b * SEQ + col);
#pragma unroll
                for (int mi = 0; mi < 4; ++mi) { const size_t row = m0 + wr * 64 + mi * 16 + fr; store4(vtm + ((size_t)b * 512 + row) * SEQ + col, acc[mi][ni] * rs); } }
        }
    }
}

DEV void phase5(const Params& p, char* smem, int dry = 0) {
    char* ws = p.ws;
    for (int it = obid(); it < 2048; it += onb()) {
        asm volatile("" ::: "memory");
        const int bh = it & 255, qb = 7 - (it >> 8), b = bh >> 3, h = bh & 7;
        const size_t t0 = (size_t)b * SEQ + qb * 256;
        __syncthreads();
        attn_item<96, 64, true, 2>((const bf16_t*)(ws + OFF_QB) + t0 * 768 + h * 96, 768,
                                (const bf16_t*)(ws + OFF_KN) + (size_t)b * SEQ * 512 + h * 64, 512, 64,
                                (const bf16_t*)(ws + OFF_KPE) + (size_t)b * SEQ * 32, 32,
                                (const bf16_t*)(ws + OFF_VTM) + ((size_t)b * 512 + h * 64) * SEQ, SEQ,
                                (qb + 1) * 4, qb * 256, 0.10206207261596577f * 1.4426950408889634f, (bf16_t*)(ws + OFF_Y) + t0 * 2048 + 512 + h * 64, 2048, smem, dry);
    }
}

DEV void phase6(const Params& p, int l, char* smem) {
    WAVE_IDS
    char* ws = p.ws;
    const bf16_t* xb = l == 0 ? (const bf16_t*)p.out : (const bf16_t*)(ws + OFF_XB1);
    const bf16_t* wm = (const bf16_t*)(ws + WOFF(WM, l)); const bf16_t* wo = (const bf16_t*)(ws + WOFF(WO, l));
    const bf16_t* Y = (const bf16_t*)(ws + OFF_Y); bf16_t* mg = (bf16_t*)(ws + OFF_MG);
    bool first_gemm = true;
    for (int it = obid(); it < 256 * 8; it += onb()) {
        asm volatile("" ::: "memory");
        const int xcd = it & 7, w = it >> 3, mt = xcd * 32 + (w >> 5) * 4 + ((w & 31) >> 3), nt = w & 7, m0 = mt * 256, n0 = nt * 128;
        f32x4 mrg[4][4]; zero_acc<4>(mrg);
        for (int n = 0; n < 4; ++n) {
            u32x2 gpk[4][4];
            {
                f32x4 ag[4][4]; zero_acc<4>(ag);
                if (first_gemm) { gemm_mainloop<4, 1, 1>(ag, xb, 1024, m0, wm + (size_t)n * 1024 * 1024, 1024, n0, 1024, smem, ((w & 7) * 2 + ((w >> 3) & 1)) & 15); first_gemm = false; }
                else gemm_mainloop<4, 1, 0>(ag, xb, 1024, m0, wm + (size_t)n * 1024 * 1024, 1024, n0, 1024, smem, ((w & 7) * 2 + ((w >> 3) & 1)) & 15);
#pragma unroll
                for (int ni = 0; ni < 4; ++ni) { const f32x4 bz = *(const f32x4*)(p.b_gate + ((size_t)l * 4 + n) * 1024 + n0 + wc * 64 + ni * 16 + fq * 4);
#pragma unroll
                    for (int mi = 0; mi < 4; ++mi) { const f32x4 v = ag[mi][ni] + bz; gpk[mi][ni] = (u32x2){pk_bf16(sigmoidf_(v[0]), sigmoidf_(v[1])), pk_bf16(sigmoidf_(v[2]), sigmoidf_(v[3]))}; } }
            }
            f32x4 ap[4][4]; zero_acc<4>(ap);
            gemm_mainloop<4, 0, 0>(ap, Y + n * 512, 2048, m0, wo + (size_t)n * 1024 * 512, 512, n0, 512, smem, w & 7);
#pragma unroll
            for (int mi = 0; mi < 4; ++mi)
#pragma unroll
                for (int ni = 0; ni < 4; ++ni) { const u32x2 g = gpk[mi][ni]; mrg[mi][ni] += (f32x4){bflo(g[0]), bfhi(g[0]), bflo(g[1]), bfhi(g[1])} * ap[mi][ni]; }
        }
        epi_plain<4>(mrg, mg, 1024, m0, n0, wr, wc, fr, fq);
    }
}
DEV void phase7(const Params& p, int l, char* smem) {
    WAVE_IDS
    char* ws = p.ws;
    const bf16_t* mg = (const bf16_t*)(ws + OFF_MG); const bf16_t* wout = (const bf16_t*)(ws + WOFF(WOUT, l)); bf16_t* o = (bf16_t*)(ws + OFF_OUT);
    for (int it = obid(); it < 256 * 4; it += onb()) {
        asm volatile("" ::: "memory");
        const int xcd = it & 7, w = it >> 3, mt = xcd * 32 + (w >> 2), nt = w & 3;
        f32x4 acc[4][8]; zero_acc8(acc);
        gemm256(acc, mg, 1024, mt * 256, wout, 1024, nt * 256, 1024, smem, ((w & 3) * 8 + ((w >> 2) & 7)) & 31);
        epi_plain8(acc, o, 1024, mt * 256, nt * 256, wr, wc, fr, fq, smem);
    }
}
DEV void phase8(const Params& p, int l) {
    char* ws = p.ws;
    const float* xin = l == 0 ? p.x : p.out; const bf16_t* o = (const bf16_t*)(ws + OFF_OUT);
    const int wid = otid() >> 6, lane = otid() & 63;
    const float alpha = 1.4142135623730951f;
    for (int t = obid() * 8 + wid; t < T_TOK; t += onb() * 8) {
        f32x4 v[4]; float sm = 0.f;
#pragma unroll
        for (int j = 0; j < 4; ++j) { const int col = j * 256 + lane * 4; const f32x4 xv = *(const f32x4*)(xin + (size_t)t * 1024 + col); const u32x2 ov = *(const u32x2*)(o + (size_t)t * 1024 + col);
            v[j] = xv * alpha + (f32x4){bflo(ov[0]), bfhi(ov[0]), bflo(ov[1]), bfhi(ov[1])}; sm += (v[j][0] + v[j][1]) + (v[j][2] + v[j][3]); }
        const float mean = wave_sum(sm) * (1.0f / 1024.0f); float sq = 0.f;
#pragma unroll
        for (int j = 0; j < 4; ++j) { v[j] -= mean; sq += (v[j][0] * v[j][0] + v[j][1] * v[j][1]) + (v[j][2] * v[j][2] + v[j][3] * v[j][3]); }
        const float rstd = rsqrtf(wave_sum(sq) * (1.0f / 1024.0f) + 1e-5f);
#pragma unroll
        for (int j = 0; j < 4; ++j) { const int col = j * 256 + lane * 4; const f32x4 g = *(const f32x4*)(p.ln_g + l * 1024 + col), bb = *(const f32x4*)(p.ln_b + l * 1024 + col);
            const f32x4 ov = v[j] * rstd * g + bb;
            *(f32x4*)(p.out + (size_t)t * 1024 + col) = ov;
            if (l == 0) store4((bf16_t*)(ws + OFF_XB1) + (size_t)t * 1024 + col, ov); }
    }
}

#ifndef REP_PH
#define REP_PH 0
#endif
#ifndef PHMASK
#define PHMASK 0x1ff
#endif

#define XB_TMO      128
#define XB_XCNT(j)  (256  + 64 * (j))
#define XB_XSUB(j)  (1280 + 64 * (j))
#define XB_XGEN(j)  (2304 + 64 * (j))
#define XB_TOP      3328
#define XB_TOPGEN   3392
#define XCD_BAR_WORDS 3456
#define XB_SPIN_CAP (1u << 18)
#define LAS __attribute__((address_space(3)))
DEV unsigned xb_ld(unsigned* p)              { return __hip_atomic_load(p, __ATOMIC_RELAXED, __HIP_MEMORY_SCOPE_AGENT); }
DEV unsigned xb_add(unsigned* p, unsigned v) { return __hip_atomic_fetch_add(p, v, __ATOMIC_RELAXED, __HIP_MEMORY_SCOPE_AGENT); }
DEV unsigned xb_xcc_id() { return (unsigned)__builtin_amdgcn_s_getreg((3 << 11) | 20) & 0xFu; }
#define XB_SPIN(cond, bar) do { unsigned _sp = 0; while (cond) { __builtin_amdgcn_s_sleep(1); \
    if ((++_sp & 255u) == 0u) { if (xb_ld(&(bar)[XB_TMO])) break; if (_sp > XB_SPIN_CAP) { atomicAdd(&(bar)[XB_TMO], 1u); break; } } } } while (0)
struct XcdBarrier { unsigned* bar; unsigned x; volatile LAS unsigned* st; };
DEV XcdBarrier xcd_barrier_post(unsigned* bar, volatile LAS unsigned* st) {
    XcdBarrier b; b.bar = bar; b.x = xb_xcc_id(); b.st = st;
    if (threadIdx.x == 0) st[3] = xb_add(&bar[XB_XCNT(b.x)], 1u);
    return b;
}
DEV void xcd_barrier_complete(unsigned* bar, unsigned x, unsigned& nloc, unsigned& nx) {
    const unsigned G = gridDim.x * gridDim.y * gridDim.z;
    unsigned sum, cnt, mine, sp = 0u;
    for (;;) {
        sum = 0u; cnt = 0u; mine = 0u;
#pragma unroll
        for (unsigned j = 0; j < 16; ++j) { const unsigned c = xb_ld(&bar[XB_XCNT(j)]); sum += c; cnt += (c > 0u) ? 1u : 0u; mine = (j == x) ? c : mine; }
        if (sum == G) break;
        __builtin_amdgcn_s_sleep(1);
        if ((++sp & 255u) == 0u) { if (xb_ld(&bar[XB_TMO])) break; if (sp > XB_SPIN_CAP) { atomicAdd(&bar[XB_TMO], 1u); break; } }
    }
    nloc = mine > 0u ? mine : 1u; nx = cnt > 0u ? cnt : 1u;
}
DEV void xcd_barrier(const XcdBarrier& b) {
    asm volatile("s_waitcnt vmcnt(0)" ::: "memory");
    __syncthreads();
    if (threadIdx.x == 0) {
        unsigned* bar = b.bar;
        __builtin_amdgcn_s_waitcnt(0);
        unsigned nloc = b.st[0], nx = b.st[1];
        if (nloc == 0u) { xcd_barrier_complete(bar, b.x, nloc, nx); b.st[0] = nloc; b.st[1] = nx; }
        const unsigned old = xb_add(&bar[XB_XSUB(b.x)], 1u);
        const unsigned gen = old / nloc;
        if (old + 1u == (gen + 1u) * nloc) {
            __builtin_amdgcn_fence(__ATOMIC_RELEASE, "agent");
            asm volatile("s_waitcnt vmcnt(0)" ::: "memory");
            const unsigned og = xb_add(&bar[XB_TOP], 1u);
            const unsigned tg = og / nx;
            if (og + 1u == (tg + 1u) * nx) xb_add(&bar[XB_TOPGEN], 1u);
            else XB_SPIN(xb_ld(&bar[XB_TOPGEN]) == tg, bar);
            __builtin_amdgcn_fence(__ATOMIC_ACQUIRE, "agent");
            xb_add(&bar[XB_XGEN(b.x)], 1u);
            asm volatile("s_waitcnt vmcnt(0)" ::: "memory");
        } else {
            XB_SPIN(xb_ld(&bar[XB_XGEN(b.x)]) == gen, bar);
            __builtin_amdgcn_fence(__ATOMIC_ACQUIRE, "agent");
            asm volatile("s_waitcnt vmcnt(0)" ::: "memory");
        }
    }
    __syncthreads();
}
constexpr size_t OFF_BAR = ((WS_END + 4095) / 4096) * 4096;
#define GSYNC_CG() do { asm volatile("s_waitcnt vmcnt(0) lgkmcnt(0)" ::: "memory"); grid.sync(); } while (0)
#define GSYNC() xcd_barrier(xb)
typedef const __attribute__((address_space(4))) Params* KParams;
DEV Params load_params() {
#if defined(__HIP_DEVICE_COMPILE__)
    auto k = __builtin_amdgcn_kernarg_segment_ptr();
    asm volatile("" : "+s"(k) :: "memory");
    return *(KParams)k;
#else
    return Params{};
#endif
}
__global__ void __launch_bounds__(NTHR) mega_fwd(Params p_unused) {
    char* smem = smem_g;
    cg::grid_group grid = cg::this_grid();
    XcdBarrier xb;
    {
        volatile LAS unsigned* st = (volatile LAS unsigned*)(smem + LDS_MAIN);
        if (threadIdx.x == 0) { st[0] = 0u; st[1] = 0u; st[2] = blockIdx.x; st[3] = 0u; }
        __syncthreads();
        const Params p = load_params();
        xb = xcd_barrier_post((unsigned*)(p.ws + OFF_BAR), st);
    }
    if (PHMASK & 1) { const Params p = load_params(); phase_prologue(p, smem); }
    GSYNC_CG();
    {
        if (threadIdx.x == 0) {
            const unsigned G = gridDim.x; bool ok = (G % 8u) == 0u;
            for (unsigned j = 0; j < 16; ++j) { const unsigned c = xb_ld(&xb.bar[XB_XCNT(j)]); ok = ok && (c == (j < 8u ? G / 8u : 0u)); }
            if (ok) xb.st[2] = xb.st[3] * 8u + xb.x;
        }
        __syncthreads();
    }
    if (REP_PH == 9) { const Params p = load_params(); phase_prologue(p, smem); GSYNC(); }
    if (REP_PH == 10) { for (int q = 0; q < 20; ++q) GSYNC(); }
    for (int l = 0; l < 2; ++l) {
        if (PHMASK & 2) { const Params p = load_params(); phase1(p, l, smem); } GSYNC();
        if (REP_PH == 1) { const Params p = load_params(); int dry = 1; asm volatile("" : "+s"(dry)); phase1(p, l, smem); GSYNC(); }
        if (PHMASK & 4) { const Params p = load_params(); phase2(p, l, smem); } GSYNC();
        if (REP_PH == 2) { const Params p = load_params(); int dry = 1; asm volatile("" : "+s"(dry)); phase2(p, l, smem, dry); GSYNC(); }
        if (REP_PH >= 31 && REP_PH <= 34) { const Params p = load_params(); int dry = 1, parts = 1 << (REP_PH - 31); asm volatile("" : "+s"(dry), "+s"(parts)); phase2(p, l, smem, dry, parts); GSYNC(); }
        if (PHMASK & 8) { const Params p = load_params(); phase3(p, l, smem); } GSYNC();
        if (REP_PH == 3) { const Params p = load_params(); int dry = 1; asm volatile("" : "+s"(dry)); phase3(p, l, smem, dry); GSYNC(); }
        if (PHMASK & 16) { const Params p = load_params(); phase4(p, l, smem); } GSYNC();
        if (REP_PH == 4) { const Params p = load_params(); int dry = 1; asm volatile("" : "+s"(dry)); phase4(p, l, smem); GSYNC(); }
        if (PHMASK & 32) { const Params p = load_params(); phase5(p, smem); } GSYNC();
        if (REP_PH == 5) { const Params p = load_params(); int dry = 1; asm volatile("" : "+s"(dry)); phase5(p, smem, dry); GSYNC(); }
        if (PHMASK & 64) { const Params p = load_params(); phase6(p, l, smem); } GSYNC();
        if (REP_PH == 6) { const Params p = load_params(); int dry = 1; asm volatile("" : "+s"(dry)); phase6(p, l, smem); GSYNC(); }
        if (PHMASK & 128) { const Params p = load_params(); phase7(p, l, smem); } GSYNC();
        if (REP_PH == 7) { const Params p = load_params(); int dry = 1; asm volatile("" : "+s"(dry)); phase7(p, l, smem); GSYNC(); }
        if (PHMASK & 256) { const Params p = load_params(); phase8(p, l); }
        if (l == 0) GSYNC();
    }
}

extern "C" void kernel_launch(void* const* d_in, const int* in_sizes, int n_in, void* d_out, int out_size, void* d_ws, size_t ws_size, hipStream_t stream) {
    static int grid_blocks = 0;
    if (grid_blocks == 0) {
        if (n_in != 28 || ws_size < OFF_BAR + XCD_BAR_WORDS * 4) { fprintf(stderr, "kernel_launch: unexpected n_in %d or ws %zu (< %zu)\n", n_in, ws_size, (size_t)WS_END); grid_blocks = -1; return; }
        int dev = 0, cus = 0, per_cu = 0;
        hipGetDevice(&dev);
        hipDeviceGetAttribute(&cus, hipDeviceAttributeMultiprocessorCount, dev);
        if (hipFuncSetAttribute((const void*)mega_fwd, hipFuncAttributeMaxDynamicSharedMemorySize, LDS_BYTES) != hipSuccess) { fprintf(stderr, "hipFuncSetAttribute failed\n"); grid_blocks = -1; return; }
        hipOccupancyMaxActiveBlocksPerMultiprocessor(&per_cu, (const void*)mega_fwd, NTHR, LDS_BYTES);
        if (per_cu < 1) { fprintf(stderr, "occupancy query returned %d\n", per_cu); grid_blocks = -1; return; }
        grid_blocks = cus * 1;
    }
    if (grid_blocks < 0) return;
    Params p{};
    p.x = (const float*)d_in[0]; p.mem = (const float*)d_in[1]; p.pos = (const int*)d_in[2]; p.w_in = (const float*)d_in[3]; p.b_gate = (const float*)d_in[4];
    p.rwkv_mu = (const float*)d_in[5]; p.rwkv_w0 = (const float*)d_in[6]; p.rwkv_w2 = (const float*)d_in[7]; p.rwkv_a0 = (const float*)d_in[8]; p.rwkv_a2 = (const float*)d_in[9];
    p.rwkv_k_k = (const float*)d_in[10]; p.rwkv_k_a = (const float*)d_in[11]; p.rwkv_r_k = (const float*)d_in[12]; p.rwkv_lnx_g = (const float*)d_in[13]; p.rwkv_lnx_b = (const float*)d_in[14];
    p.mla_q_norm = (const float*)d_in[15]; p.mla_w_uq = (const float*)d_in[16]; p.mla_kv_norm = (const float*)d_in[17]; p.mla_w_ukv = (const float*)d_in[18];
    p.conv_w = (const float*)d_in[19]; p.conv_b = (const float*)d_in[20]; p.conv_ln_g = (const float*)d_in[21]; p.conv_ln_b = (const float*)d_in[22];
    p.xattn_w = (const float*)d_in[23]; p.w_o_branch = (const float*)d_in[24]; p.w_out = (const float*)d_in[25]; p.ln_g = (const float*)d_in[26]; p.ln_b = (const float*)d_in[27];
    p.out = (float*)d_out; p.ws = (char*)d_ws;
    if (hipMemsetAsync((char*)d_ws + OFF_BAR, 0, XCD_BAR_WORDS * 4, stream) != hipSuccess) { fprintf(stderr, "memset failed\n"); return; }
    void* args[] = {&p};
    hipError_t e = hipLaunchCooperativeKernel((const void*)mega_fwd, dim3(grid_blocks), dim3(NTHR), args, LDS_BYTES, stream);
    if (e != hipSuccess) fprintf(stderr, "cooperative launch failed: %s (grid %d)\n", hipGetErrorString(e), grid_blocks);
}
```

```cpp
#include <hip/hip_runtime.h>
#include <hip/hip_cooperative_groups.h>
#include <cstdio>
#include <cstdint>
#include <cmath>
namespace cg = cooperative_groups;

typedef unsigned short bf16_t;
typedef short bf16x8 __attribute__((ext_vector_type(8)));
typedef float f32x4 __attribute__((ext_vector_type(4)));
typedef float f32x2 __attribute__((ext_vector_type(2)));
typedef unsigned u32x4 __attribute__((ext_vector_type(4)));
typedef unsigned u32x2 __attribute__((ext_vector_type(2)));

#define DEV __device__ __forceinline__

constexpr int NTHR = 512;
constexpr int T_TOK = 65536;
constexpr int SEQ = 2048;
constexpr int DM = 1024;
constexpr int IN_COLS = 10016;
constexpr int NH = 6016;
constexpr int NHP = 6144;
constexpr int LDS_MAIN = 147456;
constexpr int LDS_BYTES = LDS_MAIN + 16;
constexpr int LDSK = 80;

constexpr size_t sz_WIN = (size_t)NHP * 1024 * 2, sz_WM = (size_t)4096 * 1024 * 2, sz_WKVX = (size_t)1024 * 1024 * 2;
constexpr size_t sz_WUQ = (size_t)768 * 384 * 2, sz_WUK = (size_t)512 * 256 * 2, sz_WO = (size_t)4 * 1024 * 512 * 2, sz_WOUT = (size_t)1024 * 1024 * 2;
constexpr size_t sz_LORA = (size_t)512 * 64 * 2;
constexpr size_t R_WIN = 0, R_WM = R_WIN + sz_WIN, R_WKVX = R_WM + sz_WM, R_WUQ = R_WKVX + sz_WKVX, R_WUK = R_WUQ + sz_WUQ, R_WUV = R_WUK + sz_WUK;
constexpr size_t R_WO = R_WUV + sz_WUK, R_WOUT = R_WO + sz_WO, R_W2 = R_WOUT + sz_WOUT, R_A2 = R_W2 + sz_LORA, SZ_LW = ((R_A2 + sz_LORA + 4095) / 4096) * 4096;
constexpr size_t OFF_L1W = 0;
constexpr size_t OFF_MEMB = OFF_L1W + SZ_LW;
constexpr size_t OFF_CS = OFF_MEMB + (size_t)8192 * 1024 * 2;
constexpr size_t OFF_XK = OFF_CS + (size_t)T_TOK * 32 * 4;
constexpr size_t OFF_XVT = OFF_XK + (size_t)8192 * 512 * 2;
constexpr size_t OFF_RQ = OFF_XVT + (size_t)8192 * 512 * 2;
constexpr size_t OFF_RKV = OFF_RQ + (size_t)T_TOK * 4;
constexpr size_t OFF_Y = ((OFF_RKV + (size_t)T_TOK * 4 + 4095) / 4096) * 4096;
constexpr size_t OFF_QL = OFF_Y + (size_t)T_TOK * 2048 * 2;
constexpr size_t OFF_KVL = OFF_QL + (size_t)T_TOK * 384 * 2;
constexpr size_t OFF_KPE = OFF_KVL + (size_t)T_TOK * 256 * 2;
constexpr size_t OFF_CU = OFF_KPE + (size_t)T_TOK * 32 * 2;
constexpr size_t OFF_XQ = OFF_CU + (size_t)T_TOK * 512 * 2;
constexpr size_t OFF_RWP = OFF_XQ + (size_t)T_TOK * 512 * 2;
constexpr size_t OFF_EA = OFF_RWP + (size_t)T_TOK * 1664 * 2;
constexpr size_t OFF_XB1 = OFF_EA + (size_t)T_TOK * 1024 * 2;
constexpr size_t OFF_L0W = OFF_XB1 + (size_t)T_TOK * 1024 * 2 - SZ_LW;
constexpr size_t WS_END = OFF_XB1 + (size_t)T_TOK * 1024 * 2;
#define WOFF(NAME, l) (((l) == 0 ? OFF_L0W : OFF_L1W) + R_##NAME)
constexpr size_t OFF_MG = OFF_CU;
constexpr size_t OFF_QB = OFF_RWP;
constexpr size_t OFF_KN = OFF_QB + (size_t)T_TOK * 768 * 2;
constexpr size_t OFF_VTM = OFF_KN + (size_t)T_TOK * 512 * 2;
constexpr size_t OFF_OUT = OFF_RWP;
static_assert(OFF_VTM + (size_t)T_TOK * 512 * 2 <= OFF_XB1, "alias overflow");
static_assert(WS_END <= ((size_t)1 << 30), "workspace overflow");

struct Params {
    const float* x; const float* mem; const int* pos; const float* w_in; const float* b_gate; const float* rwkv_mu; const float* rwkv_w0;
    const float* rwkv_w2; const float* rwkv_a0; const float* rwkv_a2; const float* rwkv_k_k; const float* rwkv_k_a; const float* rwkv_r_k;
    const float* rwkv_lnx_g; const float* rwkv_lnx_b; const float* mla_q_norm; const float* mla_w_uq; const float* mla_kv_norm; const float* mla_w_ukv;
    const float* conv_w; const float* conv_b; const float* conv_ln_g; const float* conv_ln_b; const float* xattn_w; const float* w_o_branch;
    const float* w_out; const float* ln_g; const float* ln_b;
    float* out; char* ws;
};

typedef __bf16 bf16x2_t __attribute__((ext_vector_type(2)));
DEV unsigned pk_bf16(float lo, float hi) { const bf16x2_t v = __builtin_convertvector((f32x2){lo, hi}, bf16x2_t); return __builtin_bit_cast(unsigned, v); }
DEV bf16_t f2bf(float f) { return (bf16_t)(pk_bf16(f, 0.f) & 0xffffu); }
DEV float bflo(unsigned u) { return __uint_as_float(u << 16); }
DEV float bfhi(unsigned u) { return __uint_as_float(u & 0xffff0000u); }
DEV float bf2f(bf16_t h) { return __uint_as_float(((unsigned)h) << 16); }
DEV int otid() { int t = threadIdx.x; asm volatile("" : "+v"(t)); return t; }
extern __shared__ __attribute__((aligned(16))) char smem_g[];
DEV int obid() { int t = __builtin_amdgcn_readfirstlane(*(volatile int*)(smem_g + 147456 + 8)); asm volatile("" : "+s"(t)); return t; }
DEV int onb() { int t = gridDim.x; asm volatile("" : "+s"(t)); return t; }
DEV float sigmoidf_(float v) { return __builtin_amdgcn_rcpf(1.0f + __expf(-v)); }
DEV float siluf_(float v) { return v * __builtin_amdgcn_rcpf(1.0f + __expf(-v)); }
#define DPPF(v, ctrl) __builtin_bit_cast(float, __builtin_amdgcn_update_dpp(0, __builtin_bit_cast(int, (v)), (ctrl), 0xF, 0xF, true))
DEV float reduce8_dpp(float v) { v += DPPF(v, 0xB1); v += DPPF(v, 0x4E); v += DPPF(v, 0x141); return v; }
DEV float wave_sum(float v) {
#pragma unroll
    for (int o = 32; o >= 1; o >>= 1) v += __shfl_xor(v, o);
    return v;
}

template <int MI> DEV void mma_ktile(f32x4 (&acc)[MI][4], const bf16_t* sA, const bf16_t* sB, int wr, int wc, int fr, int fq) {
#pragma unroll
    for (int ks = 0; ks < 2; ++ks) {
        bf16x8 af[MI], bfr[4];
#pragma unroll
        for (int mi = 0; mi < MI; ++mi) af[mi] = *(const bf16x8*)(sA + (wr * 16 * MI + mi * 16 + fr) * LDSK + ks * 32 + fq * 8);
#pragma unroll
        for (int ni = 0; ni < 4; ++ni) bfr[ni] = *(const bf16x8*)(sB + (wc * 64 + ni * 16 + fr) * LDSK + ks * 32 + fq * 8);
#pragma unroll
        for (int mi = 0; mi < MI; ++mi)
#pragma unroll
            for (int ni = 0; ni < 4; ++ni) acc[mi][ni] = __builtin_amdgcn_mfma_f32_16x16x32_bf16(bfr[ni], af[mi], acc[mi][ni], 0, 0, 0);
    }
}

DEV void stage_rc(int b, int& R, int& C) { const int st = b >> 10, sb = b & 1023, swz = sb ^ (((sb >> 9) & 1) << 5); R = (st >> 1) * 16 + (swz >> 6); C = (st & 1) * 32 + ((swz & 63) >> 1); }
DEV void glds16(const bf16_t* g, char* l) { __builtin_amdgcn_global_load_lds((const unsigned*)g, (__attribute__((address_space(3))) unsigned*)l, 16, 0, 0); }
template <int MI, int PIPE = 1, int SYNC = 1>
DEV void gemm_mainloop(f32x4 (&acc)[MI][4], const bf16_t* A, int lda, int m0, const bf16_t* Bt, int ldb, int n0, int K, char* smem, int rot = 0) {
    constexpr int NHA = MI / 2, STG = (NHA + 1) * 16384;
    const int tid = otid(), wid = tid >> 6, lane = tid & 63, wr = wid >> 1, wc = wid & 1, fr = lane & 15, fq = lane >> 4;
    int R0, C0, R1, C1; stage_rc(tid * 16, R0, C0); stage_rc(tid * 16 + 8192, R1, C1);
    const bf16_t* gA0 = A + (size_t)(m0 + R0) * lda + C0; const bf16_t* gA1 = A + (size_t)(m0 + R1) * lda + C1;
    const bf16_t* gB0 = Bt + (size_t)(n0 + R0) * ldb + C0; const bf16_t* gB1 = Bt + (size_t)(n0 + R1) * ldb + C1;
    char* l0 = smem + tid * 16;
    const int sw = (fr * 64 + fq * 16) ^ ((fr >> 3) << 5);
    const char* rdA = smem + (wr * MI) * 2048 + sw;
    const char* rdB = smem + NHA * 16384 + (wc * 4) * 2048 + sw;
    const int nk = K / 64;
#define STAGE(stg, kt) do { char* _l = l0 + (stg) * STG; int _k = (kt) + rot; _k = _k >= nk ? _k - nk : _k; _k *= 64; \
        _Pragma("unroll") for (int h = 0; h < NHA; ++h) { glds16(gA0 + (size_t)h * 128 * lda + _k, _l + h * 16384); glds16(gA1 + (size_t)h * 128 * lda + _k, _l + h * 16384 + 8192); } \
        glds16(gB0 + _k, _l + NHA * 16384); glds16(gB1 + _k, _l + NHA * 16384 + 8192); } while (0)
#define WAITV_TILE() do { if constexpr (MI == 4) asm volatile("s_waitcnt vmcnt(6)" ::: "memory"); else asm volatile("s_waitcnt vmcnt(4)" ::: "memory"); } while (0)
    if constexpr (SYNC) __syncthreads();
    STAGE(0, 0); STAGE(1, 1); STAGE(2, 2);
    if constexpr (MI == 4) asm volatile("s_waitcnt vmcnt(12)" ::: "memory"); else asm volatile("s_waitcnt vmcnt(8)" ::: "memory");
    __builtin_amdgcn_s_barrier();
    asm volatile("" ::: "memory");
    int stg = 0;
    for (int kt = 0; kt < nk; ++kt) {
        const char* pa = rdA + stg * STG; const char* pb = rdB + stg * STG;
        bf16x8 af[2][MI], bfr[2][4];
#pragma unroll
        for (int mi = 0; mi < MI; ++mi) af[0][mi] = *(const bf16x8*)(pa + mi * 2048);
#pragma unroll
        for (int ni = 0; ni < 4; ++ni) bfr[0][ni] = *(const bf16x8*)(pb + ni * 2048);
        if constexpr (PIPE) {
#pragma unroll
            for (int mi = 0; mi < MI; ++mi) af[1][mi] = *(const bf16x8*)(pa + mi * 2048 + 1024);
#pragma unroll
            for (int ni = 0; ni < 4; ++ni) bfr[1][ni] = *(const bf16x8*)(pb + ni * 2048 + 1024);
            __builtin_amdgcn_sched_barrier(0);
        }
        __builtin_amdgcn_s_setprio(1);
#pragma unroll
        for (int mi = 0; mi < MI; ++mi)
#pragma unroll
            for (int ni = 0; ni < 4; ++ni) acc[mi][ni] = __builtin_amdgcn_mfma_f32_16x16x32_bf16(bfr[0][ni], af[0][mi], acc[mi][ni], 0, 0, 0);
        if constexpr (!PIPE) {
#pragma unroll
            for (int mi = 0; mi < MI; ++mi) af[1][mi] = *(const bf16x8*)(pa + mi * 2048 + 1024);
#pragma unroll
            for (int ni = 0; ni < 4; ++ni) bfr[1][ni] = *(const bf16x8*)(pb + ni * 2048 + 1024);
        }
        __builtin_amdgcn_sched_barrier(0);
        if (kt + 2 < nk) WAITV_TILE(); else asm volatile("s_waitcnt vmcnt(0)" ::: "memory");
        asm volatile("s_waitcnt lgkmcnt(0)" ::: "memory");
        __builtin_amdgcn_s_barrier();
        asm volatile("" ::: "memory");
        if (kt + 3 < nk) STAGE(stg, kt + 3);
        __builtin_amdgcn_sched_barrier(0);
#pragma unroll
        for (int mi = 0; mi < MI; ++mi)
#pragma unroll
            for (int ni = 0; ni < 4; ++ni) acc[mi][ni] = __builtin_amdgcn_mfma_f32_16x16x32_bf16(bfr[1][ni], af[1][mi], acc[mi][ni], 0, 0, 0);
        __builtin_amdgcn_s_setprio(0);
        stg = stg == 2 ? 0 : stg + 1;
    }
#undef STAGE
#undef WAITV_TILE
}

DEV void gemm256(f32x4 (&acc)[4][8], const bf16_t* A, int lda, int m0, const bf16_t* Bt, int ldb, int n0, int K, char* smem, int rot = 0) {
    const int tid = otid(), wid = tid >> 6, lane = tid & 63, wr = wid >> 1, wc = wid & 1, fr = lane & 15, fq = lane >> 4;
    int R, C; { const int b = tid * 16, st = b >> 10, sb = b & 1023, swz = sb ^ (((sb >> 9) & 1) << 5); R = st * 16 + (swz >> 6); C = (swz & 63) >> 1; }
    const bf16_t* gA = A + (size_t)(m0 + R) * lda + C;
    const bf16_t* gB = Bt + (size_t)(n0 + R) * ldb + C;
    const size_t hA = (size_t)128 * lda, hB = (size_t)128 * ldb;
    char* l0 = smem + tid * 16;
    const int sw = (fr * 64 + fq * 16) ^ ((fr >> 3) << 5);
    const char* rdA = smem + (wr * 4) * 1024 + sw;
    const char* rdB = smem + 16384 + wc * 8192 + sw;
    const int nk = K / 32;
#define STAGE(stg, kt) do { char* _l = l0 + (stg) * 32768; int _k = (kt) + rot; _k = _k >= nk ? _k - nk : _k; _k *= 32; glds16(gA + _k, _l); glds16(gA + hA + _k, _l + 8192); glds16(gB + _k, _l + 16384); glds16(gB + hB + _k, _l + 24576); } while (0)
    __syncthreads();
    STAGE(0, 0); STAGE(1, 1); STAGE(2, 2); STAGE(3, 3);
    asm volatile("s_waitcnt vmcnt(12)" ::: "memory");
    __builtin_amdgcn_s_barrier();
    asm volatile("" ::: "memory");
    for (int kt = 0; kt < nk; ++kt) {
        const int stg = kt & 3;
        const char* pa = rdA + stg * 32768; const char* pb = rdB + stg * 32768;
        bf16x8 af[4], bfr[8];
#pragma unroll
        for (int mi = 0; mi < 4; ++mi) af[mi] = *(const bf16x8*)(pa + mi * 1024);
#pragma unroll
        for (int ni = 0; ni < 8; ++ni) bfr[ni] = *(const bf16x8*)(pb + ni * 1024);
        __builtin_amdgcn_sched_barrier(0);
        __builtin_amdgcn_s_setprio(1);
#pragma unroll
        for (int ni = 0; ni < 4; ++ni)
#pragma unroll
            for (int mi = 0; mi < 4; ++mi) acc[mi][ni] = __builtin_amdgcn_mfma_f32_16x16x32_bf16(bfr[ni], af[mi], acc[mi][ni], 0, 0, 0);
        __builtin_amdgcn_sched_barrier(0);
        if (kt + 3 < nk) asm volatile("s_waitcnt vmcnt(8)" ::: "memory");
        else if (kt + 2 < nk) asm volatile("s_waitcnt vmcnt(4)" ::: "memory");
        else asm volatile("s_waitcnt vmcnt(0)" ::: "memory");
        asm volatile("s_waitcnt lgkmcnt(0)" ::: "memory");
        __builtin_amdgcn_s_barrier();
        asm volatile("" ::: "memory");
        if (kt + 4 < nk) STAGE(stg, kt + 4);
        __builtin_amdgcn_sched_barrier(0);
#pragma unroll
        for (int ni = 4; ni < 8; ++ni)
#pragma unroll
            for (int mi = 0; mi < 4; ++mi) acc[mi][ni] = __builtin_amdgcn_mfma_f32_16x16x32_bf16(bfr[ni], af[mi], acc[mi][ni], 0, 0, 0);
        __builtin_amdgcn_s_setprio(0);
    }
#undef STAGE
}
DEV void zero_acc8(f32x4 (&acc)[4][8]) {
#pragma unroll
    for (int mi = 0; mi < 4; ++mi)
#pragma unroll
        for (int ni = 0; ni < 8; ++ni) acc[mi][ni] = (f32x4){0.f, 0.f, 0.f, 0.f};
}
template <int MI> DEV void zero_acc(f32x4 (&acc)[MI][4]) {
#pragma unroll
    for (int mi = 0; mi < MI; ++mi)
#pragma unroll
        for (int ni = 0; ni < 4; ++ni) acc[mi][ni] = (f32x4){0.f, 0.f, 0.f, 0.f};
}
DEV void store4(bf16_t* p, f32x4 v) { *(u32x2*)p = (u32x2){pk_bf16(v[0], v[1]), pk_bf16(v[2], v[3])}; }

#define WAVE_IDS const int tid = otid(), wid = tid >> 6, lane = tid & 63, wr = wid >> 1, wc = wid & 1, fr = lane & 15, fq = lane >> 4; (void)wid; (void)lane; (void)wr; (void)wc; (void)fr; (void)fq;

template <class Map>
DEV void cvt_transpose(const float* src, int ld, int K, int Ndst, bf16_t* dst, Map map, const float* kscale, char* smem) {
    float* t = (float*)smem;
    const int ntn = Ndst / 64, ntk = K / 64, tid = otid();
    for (int tile = obid(); tile < ntn * ntk; tile += onb()) {
        const int tn = tile % ntn, tk = tile / ntn;
        __syncthreads();
#pragma unroll
        for (int i = 0; i < 2; ++i) {
            const int e = tid + i * NTHR, kk = e >> 4, n4 = (e & 15) * 4; const int sc = map(tn * 64 + n4);
            f32x4 v = (f32x4){0.f, 0.f, 0.f, 0.f};
            if (sc >= 0) { v = *(const f32x4*)(src + (size_t)(tk * 64 + kk) * ld + sc); if (kscale) v *= kscale[tk * 64 + kk]; }
            t[(n4 + 0) * 65 + kk] = v[0]; t[(n4 + 1) * 65 + kk] = v[1]; t[(n4 + 2) * 65 + kk] = v[2]; t[(n4 + 3) * 65 + kk] = v[3];
        }
        __syncthreads();
        { const int nn = tid >> 3, k8 = (tid & 7) * 8; const float* r = t + nn * 65 + k8;
          *(u32x4*)(dst + (size_t)(tn * 64 + nn) * K + tk * 64 + k8) = (u32x4){pk_bf16(r[0], r[1]), pk_bf16(r[2], r[3]), pk_bf16(r[4], r[5]), pk_bf16(r[6], r[7])}; }
    }
}
DEV int map_h(int n) {
    if (n < 2816) return n;
    if (n < 3328) return n + 32;
    if (n < 4352) { const int j = n - 3328, tile = j >> 7, jj = j & 127, sub = jj >> 4, i = jj & 15; return 3360 + tile * 64 + (sub >> 1) * 16 + i + ((sub & 1) ? 512 : 0); }
    if (n < 5888) return n + 32;
    if (n < 5920) return 2816 + (n - 5888);
    return -1;
}
DEV void phase_prologue(const Params& p, char* smem) {
    char* ws = p.ws;
    for (int l = 0; l < 2; ++l) {
        cvt_transpose(p.w_in + (size_t)l * 1024 * IN_COLS, IN_COLS, 1024, NH, (bf16_t*)(ws + WOFF(WIN, l)), [](int n) { return map_h(n); }, nullptr, smem);
        cvt_transpose(p.w_in + (size_t)l * 1024 * IN_COLS, IN_COLS, 1024, 4096, (bf16_t*)(ws + WOFF(WM, l)), [](int n) { return 5920 + n; }, nullptr, smem);
        cvt_transpose(p.xattn_w + (size_t)l * 1024 * 1024, 1024, 1024, 1024, (bf16_t*)(ws + WOFF(WKVX, l)), [](int n) { return n; }, nullptr, smem);
        cvt_transpose(p.mla_w_uq + (size_t)l * 384 * 768, 768, 384, 768, (bf16_t*)(ws + WOFF(WUQ, l)), [](int n) { return n; }, p.mla_q_norm + l * 384, smem);
        cvt_transpose(p.mla_w_ukv + (size_t)l * 256 * 1024, 1024, 256, 512, (bf16_t*)(ws + WOFF(WUK, l)), [](int n) { return (n >> 6) * 128 + (n & 63); }, p.mla_kv_norm + l * 256, smem);
        cvt_transpose(p.mla_w_ukv + (size_t)l * 256 * 1024, 1024, 256, 512, (bf16_t*)(ws + WOFF(WUV, l)), [](int n) { return (n >> 6) * 128 + 64 + (n & 63); }, p.mla_kv_norm + l * 256, smem);
        for (int n = 0; n < 4; ++n)
            cvt_transpose(p.w_o_branch + ((size_t)l * 4 + n) * 512 * 1024, 1024, 512, 1024, (bf16_t*)(ws + WOFF(WO, l)) + (size_t)n * 1024 * 512, [](int c) { return c; }, nullptr, smem);
        cvt_transpose(p.w_out + (size_t)l * 1024 * 1024, 1024, 1024, 1024, (bf16_t*)(ws + WOFF(WOUT, l)), [](int n) { return n; }, nullptr, smem);
        cvt_transpose(p.rwkv_w2 + (size_t)l * 64 * 512, 512, 64, 512, (bf16_t*)(ws + WOFF(W2, l)), [](int n) { return n; }, nullptr, smem);
        cvt_transpose(p.rwkv_a2 + (size_t)l * 64 * 512, 512, 64, 512, (bf16_t*)(ws + WOFF(A2, l)), [](int n) { return n; }, nullptr, smem);
    }
    {
        const size_t n4 = (size_t)T_TOK * 1024 / 4; bf16_t* xb = (bf16_t*)p.out;
        for (size_t i = (size_t)obid() * NTHR + otid(); i < n4; i += (size_t)onb() * NTHR) { const f32x4 v = *(const f32x4*)(p.x + i * 4); store4(xb + i * 4, v); }
    }
    {
        const size_t n4 = (size_t)8192 * 1024 / 4; bf16_t* mb = (bf16_t*)(ws + OFF_MEMB);
        for (size_t i = (size_t)obid() * NTHR + otid(); i < n4; i += (size_t)onb() * NTHR) { const f32x4 v = *(const f32x4*)(p.mem + i * 4); store4(mb + i * 4, v); }
    }
    {
        float* cs = (float*)(ws + OFF_CS);
        for (size_t i = (size_t)obid() * NTHR + otid(); i < (size_t)T_TOK * 16; i += (size_t)onb() * NTHR) {
            const int t = (int)(i >> 4), j = (int)(i & 15);
            const float inv = (float)exp2(-(double)j * (13.287712379549449 / 16.0));
            const float ang = (float)p.pos[t] * inv;
            double rev = (double)ang * 0.15915494309189535; rev -= rint(rev);
            cs[(size_t)t * 32 + j] = __builtin_amdgcn_cosf((float)rev); cs[(size_t)t * 32 + 16 + j] = __builtin_amdgcn_sinf((float)rev);
        }
    }
}

DEV void bounce_put(char* reg, int mi, int ns, int fr, int fq, f32x4 v) { *(u32x2*)(reg + (mi * 16 + fr) * 272 + (ns * 16 + fq * 4) * 2) = (u32x2){pk_bf16(v[0], v[1]), pk_bf16(v[2], v[3])}; }
template <int NS> DEV void bounce_flush(const char* reg, bf16_t* dst, int ld, int lane) {
    constexpr int CH = NS * 2, RPP = 64 / CH;
    const int chunk = lane % CH, rsub = lane / CH;
    __builtin_amdgcn_sched_barrier(0);
#pragma unroll
    for (int ps = 0; ps < CH; ++ps) { const int row = ps * RPP + rsub; *(u32x4*)(dst + (size_t)row * ld + chunk * 8) = *(const u32x4*)(reg + row * 272 + chunk * 16);
        if ((ps & 3) == 3) __builtin_amdgcn_sched_barrier(0); }
}
DEV u32x2 pk4(f32x4 v) { return (u32x2){pk_bf16(v[0], v[1]), pk_bf16(v[2], v[3])}; }
DEV void epi_h(const Params& p, const f32x4 (&acc)[4][8], int m0, int n0g, int, int, int, int, char* smem) {
    const int tid_ = otid(), wid__ = tid_ >> 6, wr = wid__ >> 1, wc = wid__ & 1, fr = tid_ & 15, fq = (tid_ & 63) >> 4;
    char* ws = p.ws; const int n0 = n0g + wc * 128, ti = n0 >> 7;
    if (ti >= 47) return;
    bf16_t* dst = nullptr; int ld = 0, coff = 0, mode = 0;
    if (ti < 13) { dst = (bf16_t*)(ws + OFF_RWP); ld = 1664; coff = n0; }
    else if (ti < 17) { dst = (bf16_t*)(ws + OFF_Y); ld = 2048; coff = n0 - 1664; mode = 1; }
    else if (ti < 20) { dst = (bf16_t*)(ws + OFF_QL); ld = 384; coff = n0 - 2176; }
    else if (ti < 22) { dst = (bf16_t*)(ws + OFF_KVL); ld = 256; coff = n0 - 2560; }
    else if (ti < 26) { dst = (bf16_t*)(ws + OFF_Y); ld = 2048; coff = 512 + n0 - 2816; mode = 1; }
    else if (ti < 34) { dst = (bf16_t*)(ws + OFF_CU); ld = 512; coff = (ti - 26) * 64; mode = 2; }
    else if (ti < 38) { dst = (bf16_t*)(ws + OFF_Y); ld = 2048; coff = 1024 + n0 - 4352; mode = 1; }
    else if (ti < 42) { dst = (bf16_t*)(ws + OFF_XQ); ld = 512; coff = n0 - 4864; }
    else if (ti < 46) { dst = (bf16_t*)(ws + OFF_Y); ld = 2048; coff = 1536 + n0 - 5376; mode = 1; }
    else { dst = (bf16_t*)(ws + OFF_KPE); ld = 32; mode = 3; }
    const int mbase = m0 + wr * 64;
    const int lane_ = fq * 16 + fr; char* reg = smem + (wr * 2 + wc) * 17408;
    if (mode <= 1) {
#pragma unroll
        for (int mi = 0; mi < 4; ++mi)
#pragma unroll
            for (int ni = 0; ni < 8; ++ni) { f32x4 v = acc[mi][ni]; if (mode == 1) { v[0] = siluf_(v[0]); v[1] = siluf_(v[1]); v[2] = siluf_(v[2]); v[3] = siluf_(v[3]); } bounce_put(reg, mi, ni, fr, fq, v); }
        bounce_flush<8>(reg, dst + (size_t)mbase * ld + coff, ld, lane_);
    } else if (mode == 2) {
#pragma unroll
        for (int mi = 0; mi < 4; ++mi)
#pragma unroll
            for (int pp = 0; pp < 4; ++pp) { const f32x4 a = acc[mi][2 * pp], g = acc[mi][2 * pp + 1]; f32x4 v;
                v[0] = a[0] * sigmoidf_(g[0]); v[1] = a[1] * sigmoidf_(g[1]); v[2] = a[2] * sigmoidf_(g[2]); v[3] = a[3] * sigmoidf_(g[3]); bounce_put(reg, mi, pp, fr, fq, v); }
        bounce_flush<4>(reg, dst + (size_t)mbase * ld + coff, ld, lane_);
    } else {
        const float* cs = (const float*)(ws + OFF_CS);
#pragma unroll
        for (int mi = 0; mi < 4; ++mi) { const size_t row = mbase + mi * 16 + fr;
            const f32x4 c = *(const f32x4*)(cs + row * 32 + fq * 4), s = *(const f32x4*)(cs + row * 32 + 16 + fq * 4);
            const f32x4 x1 = acc[mi][0], x2 = acc[mi][1];
            store4(dst + row * 32 + fq * 4, x1 * c - x2 * s); store4(dst + row * 32 + 16 + fq * 4, x1 * s + x2 * c); }
    }
}
template <int MI> DEV void epi_plain(const f32x4 (&acc)[MI][4], bf16_t* dst, int ld, int m0, int n0, int, int, int, int) {
    const int tid_ = otid(), wid__ = tid_ >> 6, wr = wid__ >> 1, wc = wid__ & 1, fr = tid_ & 15, fq = (tid_ & 63) >> 4;
#pragma unroll
    for (int mi = 0; mi < MI; ++mi) { const size_t row = m0 + wr * 16 * MI + mi * 16 + fr;
#pragma unroll
        for (int ni = 0; ni < 4; ++ni) store4(dst + row * ld + n0 + wc * 64 + ni * 16 + fq * 4, acc[mi][ni]); }
}
DEV void epi_plain8(const f32x4 (&acc)[4][8], bf16_t* dst, int ld, int m0, int n0, int, int, int, int, char* smem) {
    const int tid_ = otid(), wid__ = tid_ >> 6, wr = wid__ >> 1, wc = wid__ & 1, fr = tid_ & 15, fq = (tid_ & 63) >> 4;
    char* reg = smem + (wr * 2 + wc) * 17408;
#pragma unroll
    for (int mi = 0; mi < 4; ++mi)
#pragma unroll
        for (int ni = 0; ni < 8; ++ni) bounce_put(reg, mi, ni, fr, fq, acc[mi][ni]);
    bounce_flush<8>(reg, dst + (size_t)(m0 + wr * 64) * ld + n0 + wc * 128, ld, fq * 16 + fr);
}
DEV void phase1(const Params& p, int l, char* smem) {
    WAVE_IDS
    char* ws = p.ws;
    const bf16_t* xb = l == 0 ? (const bf16_t*)p.out : (const bf16_t*)(ws + OFF_XB1);
    const bf16_t* win = (const bf16_t*)(ws + WOFF(WIN, l));
    const bf16_t* wkv = (const bf16_t*)(ws + WOFF(WKVX, l));
    const bf16_t* memb = (const bf16_t*)(ws + OFF_MEMB);
    const int nb = onb(), bid = obid();
    const int n_main = 256 * 24, n_items = n_main + 128;
    for (int it = bid; it < n_items; it += nb) {
        asm volatile("" ::: "memory");
        f32x4 acc[4][8]; zero_acc8(acc);
        if (it < n_main) {
            const int xcd = it & 7, w = it >> 3;
            const int g = w >> 5, within = w & 31, mtg = g / 6, ntg = g % 6;
            const int mt = xcd * 32 + mtg * 8 + (within >> 2), nt = ntg * 4 + (within & 3);
            gemm256(acc, xb, 1024, mt * 256, win, 1024, nt * 256, 1024, smem, ((within & 3) * 8 + (within >> 2)) & 31);
            epi_h(p, acc, mt * 256, nt * 256, wr, wc, fr, fq, smem);
        } else if (it < n_main + 64) {
            const int j = it - n_main, mt = j >> 1, nt = j & 1;
            gemm256(acc, memb, 1024, mt * 256, wkv, 1024, nt * 256, 1024, smem);
            epi_plain8(acc, (bf16_t*)(ws + OFF_XK), 512, mt * 256, nt * 256, wr, wc, fr, fq, smem);
        } else {
            const int j = it - n_main - 64, b = j >> 1, mt = j & 1;
            gemm256(acc, wkv + (size_t)512 * 1024, 1024, mt * 256, memb + (size_t)b * 256 * 1024, 1024, 0, 1024, smem);
            epi_plain8(acc, (bf16_t*)(ws + OFF_XVT) + (size_t)b * 512 * 256, 256, mt * 256, 0, wr, wc, fr, fq, smem);
        }
    }
}

template <int DQK, int DV, bool CAUSAL, int MIA>
DEV void attn_item(const bf16_t* Q, int ldq, const bf16_t* K1, int ldk1, int D1, const bf16_t* K2, int ldk2, const bf16_t* Vt, int ldvt,
                   int nkt, int q0, float scale_log2, bf16_t* Yp, int ldy, char* smem, int dry = 0) {
    constexpr int LDK = DQK + 16, LDV = 72, KCH = DQK / 8;
    constexpr int NKC = 64 * KCH / NTHR + ((64 * KCH) % NTHR ? 1 : 0), NVC = DV * 8 / NTHR;
    bf16_t* sK = (bf16_t*)smem;
    bf16_t* sV = sK + 64 * LDK;
    constexpr int STG = 64 * LDK + DV * LDV;
    const int tid = otid(), w = tid >> 6, lane = tid & 63, fr = lane & 15, fq = lane >> 4;
    bf16x8 qf[MIA][DQK / 32];
#pragma unroll
    for (int mi = 0; mi < MIA; ++mi)
#pragma unroll
        for (int ks = 0; ks < DQK / 32; ++ks) qf[mi][ks] = *(const bf16x8*)(Q + (size_t)(w * 16 * MIA + mi * 16 + fr) * ldq + ks * 32 + fq * 8);
    f32x4 o[MIA][DV / 16];
#pragma unroll
    for (int mi = 0; mi < MIA; ++mi)
#pragma unroll
        for (int di = 0; di < DV / 16; ++di) o[mi][di] = (f32x4){0.f, 0.f, 0.f, 0.f};
    float mrun[MIA], lrun[MIA];
#pragma unroll
    for (int mi = 0; mi < MIA; ++mi) { mrun[mi] = -1e30f; lrun[mi] = 0.f; }
    u32x4 kreg[NKC], vreg[NVC];
    auto gload = [&](int kt) {
#pragma unroll
        for (int i = 0; i < NKC; ++i) { const int c = tid + i * NTHR; if (c < 64 * KCH) { const int row = c / KCH, col = (c % KCH) * 8;
            kreg[i] = col < D1 ? *(const u32x4*)(K1 + (size_t)(kt * 64 + row) * ldk1 + col) : *(const u32x4*)(K2 + (size_t)(kt * 64 + row) * ldk2 + (col - D1)); } }
#pragma unroll
        for (int i = 0; i < NVC; ++i) { const int c = tid + i * NTHR, d = c >> 3, ch = c & 7; vreg[i] = *(const u32x4*)(Vt + (size_t)d * ldvt + kt * 64 + ch * 8); }
    };
    auto sstore = [&](int buf) {
#pragma unroll
        for (int i = 0; i < NKC; ++i) { const int c = tid + i * NTHR; if (c < 64 * KCH) { const int row = c / KCH, col = (c % KCH) * 8; *(u32x4*)(sK + buf * STG + row * LDK + col) = kreg[i]; } }
#pragma unroll
        for (int i = 0; i < NVC; ++i) { const int c = tid + i * NTHR, d = c >> 3, ch = c & 7; *(u32x4*)(sV + buf * STG + d * LDV + ch * 8) = vreg[i]; }
    };
    gload(0);
    __syncthreads();
    sstore(0);
    if (nkt > 1) gload(1);
    __syncthreads();
    int slot = 0;
    for (int kt = 0; kt < nkt; ++kt) {
        const int nslot = slot == 2 ? 0 : slot + 1;
        const bf16_t* cK = sK + slot * STG; const bf16_t* cV = sV + slot * STG;
        if (kt + 1 < nkt) { sstore(nslot); if (kt + 2 < nkt) gload(kt + 2); }
        const bool live = !(CAUSAL && kt * 64 > q0 + w * 16 * MIA + 16 * MIA - 1);
        f32x4 s[MIA][4];
        if (live) {
#pragma unroll
        for (int mi = 0; mi < MIA; ++mi)
#pragma unroll
            for (int ni = 0; ni < 4; ++ni) s[mi][ni] = (f32x4){0.f, 0.f, 0.f, 0.f};
#pragma unroll
        for (int ks = 0; ks < DQK / 32; ++ks)
#pragma unroll
            for (int ni = 0; ni < 4; ++ni) { const bf16x8 kf = *(const bf16x8*)(cK + (ni * 16 + fr) * LDK + ks * 32 + fq * 8);
#pragma unroll
                for (int mi = 0; mi < MIA; ++mi) s[mi][ni] = __builtin_amdgcn_mfma_f32_16x16x32_bf16(kf, qf[mi][ks], s[mi][ni], 0, 0, 0); }
        }
        __syncthreads();
        slot = nslot;
        if (live) {
        bf16x8 pf[MIA][2];
#pragma unroll
        for (int mi = 0; mi < MIA; ++mi) {
            float mx = -1e30f;
            if (CAUSAL && kt * 64 + 63 > q0 + w * 16 * MIA) {
                const int qabs = q0 + w * 16 * MIA + mi * 16 + fr;
#pragma unroll
                for (int ni = 0; ni < 4; ++ni)
#pragma unroll
                    for (int r = 0; r < 4; ++r) { const int kabs = kt * 64 + ni * 16 + fq * 4 + r; if (kabs > qabs) s[mi][ni][r] = -1e30f; }
            }
#pragma unroll
            for (int ni = 0; ni < 4; ++ni) mx = fmaxf(mx, fmaxf(fmaxf(s[mi][ni][0], s[mi][ni][1]), fmaxf(s[mi][ni][2], s[mi][ni][3])));
            mx = fmaxf(mx, __shfl_xor(mx, 16)); mx = fmaxf(mx, __shfl_xor(mx, 32));
            const float mnew = fmaxf(mrun[mi], mx);
            const float mc = mnew * scale_log2;
            float ps = 0.f;
#pragma unroll
            for (int ni = 0; ni < 4; ++ni)
#pragma unroll
                for (int r = 0; r < 4; ++r) { const float pv = __builtin_amdgcn_exp2f(__builtin_fmaf(s[mi][ni][r], scale_log2, -mc)); s[mi][ni][r] = pv; ps += pv; }
            if (__builtin_amdgcn_ballot_w64(mnew > mrun[mi]) != 0ull) {
                const float alpha = __builtin_amdgcn_exp2f((mrun[mi] - mnew) * scale_log2);
                lrun[mi] *= alpha;
#pragma unroll
                for (int di = 0; di < DV / 16; ++di) o[mi][di] *= alpha;
            }
            mrun[mi] = mnew;
            lrun[mi] += ps;
#pragma unroll
            for (int s2 = 0; s2 < 2; ++s2) { const f32x4 a = s[mi][2 * s2], b = s[mi][2 * s2 + 1];
                const u32x4 pk = (u32x4){pk_bf16(a[0], a[1]), pk_bf16(a[2], a[3]), pk_bf16(b[0], b[1]), pk_bf16(b[2], b[3])};
                pf[mi][s2] = __builtin_bit_cast(bf16x8, pk); }
        }
#pragma unroll
        for (int di = 0; di < DV / 16; ++di)
#pragma unroll
            for (int s2 = 0; s2 < 2; ++s2) {
                const u32x2 v0 = *(const u32x2*)(cV + (di * 16 + fr) * LDV + s2 * 32 + fq * 4), v1 = *(const u32x2*)(cV + (di * 16 + fr) * LDV + s2 * 32 + 16 + fq * 4);
                const bf16x8 vf = __builtin_bit_cast(bf16x8, ((u32x4){v0[0], v0[1], v1[0], v1[1]}));
#pragma unroll
                for (int mi = 0; mi < MIA; ++mi) o[mi][di] = __builtin_amdgcn_mfma_f32_16x16x32_bf16(vf, pf[mi][s2], o[mi][di], 0, 0, 0);
            }
        }
    }
#pragma unroll
    for (int mi = 0; mi < MIA; ++mi) {
        float lt = lrun[mi]; lt += __shfl_xor(lt, 16); lt += __shfl_xor(lt, 32);
        const float inv = __builtin_amdgcn_rcpf(lt);
        bf16_t* yrow = Yp + (size_t)(w * 16 * MIA + mi * 16 + fr) * ldy;
#pragma unroll
        for (int di = 0; di < DV / 16; ++di) { bf16_t* yp = yrow + di * 16 + fq * 4; const u32x2 g = *(const u32x2*)yp;
            f32x4 v = o[mi][di] * inv; v[0] *= bflo(g[0]); v[1] *= bfhi(g[0]); v[2] *= bflo(g[1]); v[3] *= bfhi(g[1]); if (!dry) store4(yp, v); }
    }
}

DEV void lora_item(const Params& p, int l, int mt, int which, char* smem) {
    WAVE_IDS
    char* ws = p.ws;
    bf16_t* sA = (bf16_t*)smem; bf16_t* sB = sA + 256 * LDSK;
    const bf16_t* rwp = (const bf16_t*)(ws + OFF_RWP);
    const bf16_t* wt = (const bf16_t*)(ws + (which ? WOFF(A2, l) : WOFF(W2, l)));
    const int colb = 1536 + which * 64;
    const float* mu = p.rwkv_mu + l * 1664 + colb;
    const float* bias = (which ? p.rwkv_a0 : p.rwkv_w0) + l * 512;
    bf16_t* ea = (bf16_t*)(ws + OFF_EA) + which * 512;
    __syncthreads();
    const int crow = tid >> 3, cch = tid & 7;
    u32x4 breg[8];
#pragma unroll
    for (int i = 0; i < 8; ++i) breg[i] = *(const u32x4*)(wt + (size_t)(crow + i * 64) * 64 + cch * 8);
#pragma unroll
    for (int i = 0; i < 4; ++i) {
        const int row = crow + i * 64; const size_t t = (size_t)mt * 256 + row;
        const u32x4 cur = *(const u32x4*)(rwp + t * 1664 + colb + cch * 8);
        u32x4 prv = (u32x4){0u, 0u, 0u, 0u};
        if ((t & (SEQ - 1)) != 0) prv = *(const u32x4*)(rwp + (t - 1) * 1664 + colb + cch * 8);
        float v[8];
#pragma unroll
        for (int j = 0; j < 4; ++j) { const float c0 = bflo(cur[j]), c1 = bfhi(cur[j]), p0 = bflo(prv[j]), p1 = bfhi(prv[j]);
            v[2 * j] = c0 + mu[cch * 8 + 2 * j] * (p0 - c0); v[2 * j + 1] = c1 + mu[cch * 8 + 2 * j + 1] * (p1 - c1); }
        if (which == 0) {
#pragma unroll
            for (int j = 0; j < 8; ++j) { const float e2 = __expf(2.0f * v[j]); v[j] = 1.0f - 2.0f * __builtin_amdgcn_rcpf(e2 + 1.0f); }
        }
        *(u32x4*)(sA + row * LDSK + cch * 8) = (u32x4){pk_bf16(v[0], v[1]), pk_bf16(v[2], v[3]), pk_bf16(v[4], v[5]), pk_bf16(v[6], v[7])};
    }
#pragma unroll
    for (int i = 0; i < 8; ++i) *(u32x4*)(sB + (crow + i * 64) * LDSK + cch * 8) = breg[i];
    __syncthreads();
    for (int nt = 0; nt < 4; ++nt) {
        f32x4 acc[4][4]; zero_acc<4>(acc);
        mma_ktile<4>(acc, sA, sB + nt * 128 * LDSK, wr, wc, fr, fq);
#pragma unroll
        for (int mi = 0; mi < 4; ++mi) { const size_t row = (size_t)mt * 256 + wr * 64 + mi * 16 + fr;
#pragma unroll
            for (int ni = 0; ni < 4; ++ni) { const int col = nt * 128 + wc * 64 + ni * 16 + fq * 4; const f32x4 bz = *(const f32x4*)(bias + col); f32x4 v = acc[mi][ni] + bz;
#pragma unroll
                for (int r = 0; r < 4; ++r) { const float sg = sigmoidf_(v[r]); v[r] = which ? sg : 0.6065306597f * sg; }
                store4(ea + row * 1024 + col, v); } }
    }
}
DEV void conv_item(const Params& p, int l, int tile, char* smem, int dry) {
    char* ws = p.ws;
    bf16_t* sin_ = (bf16_t*)smem;
    float* sout = (float*)(smem + 62 * 1024);
    const bf16_t* cu = (const bf16_t*)(ws + OFF_CU);
    bf16_t* Y = (bf16_t*)(ws + OFF_Y);
    const int tid = otid(), wid = tid >> 6, lane = tid & 63;
    const int t0 = tile * 32, s0 = t0 & (SEQ - 1);
    __syncthreads();
    for (int c = tid; c < 62 * 64; c += NTHR) { const int row = c >> 6, ch = c & 63; const int srel = s0 - 30 + row;
        u32x4 v = (u32x4){0u, 0u, 0u, 0u};
        if (srel >= 0) v = *(const u32x4*)(cu + (size_t)(t0 - 30 + row) * 512 + ch * 8);
        *(u32x4*)(sin_ + row * 512 + ch * 8) = v; }
    float w[31];
#pragma unroll
    for (int j = 0; j < 31; ++j) w[j] = p.conv_w[((size_t)l * 31 + j) * 512 + tid];
    const float cb = p.conv_b[l * 512 + tid];
    __syncthreads();
    {
        float acc[32];
#pragma unroll
        for (int t = 0; t < 32; ++t) acc[t] = cb;
#pragma unroll
        for (int r = 0; r < 62; ++r) {
            const float xv = bf2f(sin_[r * 512 + tid]);
#pragma unroll
            for (int t = 0; t < 32; ++t) if (r - t >= 0 && r - t <= 30) acc[t] += w[r - t] * xv;
        }
#pragma unroll
        for (int t = 0; t < 32; ++t) sout[t * 512 + tid] = acc[t];
    }
    __syncthreads();
    const f32x4 g0 = *(const f32x4*)(p.conv_ln_g + l * 512 + lane * 8), g1 = *(const f32x4*)(p.conv_ln_g + l * 512 + lane * 8 + 4);
    const f32x4 b0 = *(const f32x4*)(p.conv_ln_b + l * 512 + lane * 8), b1 = *(const f32x4*)(p.conv_ln_b + l * 512 + lane * 8 + 4);
#pragma unroll 1
    for (int t = wid; t < 32; t += 8) {
        const f32x4 x0 = *(const f32x4*)(sout + t * 512 + lane * 8), x1 = *(const f32x4*)(sout + t * 512 + lane * 8 + 4);
        float sm = (x0[0] + x0[1]) + (x0[2] + x0[3]) + (x1[0] + x1[1]) + (x1[2] + x1[3]);
        const float mean = wave_sum(sm) * (1.0f / 512.0f);
        const f32x4 d0 = x0 - mean, d1 = x1 - mean;
        float sq = (d0[0] * d0[0] + d0[1] * d0[1]) + (d0[2] * d0[2] + d0[3] * d0[3]) + (d1[0] * d1[0] + d1[1] * d1[1]) + (d1[2] * d1[2] + d1[3] * d1[3]);
        const float rstd = rsqrtf(wave_sum(sq) * (1.0f / 512.0f) + 1e-5f);
        bf16_t* yp = Y + (size_t)(t0 + t) * 2048 + 1024 + lane * 8;
        const u32x4 g = *(const u32x4*)yp;
        f32x4 y0 = d0 * rstd * g0 + b0, y1 = d1 * rstd * g1 + b1;
        float o[8];
#pragma unroll
        for (int j = 0; j < 4; ++j) { o[j] = siluf_(y0[j]); o[4 + j] = siluf_(y1[j]); }
#pragma unroll
        for (int j = 0; j < 4; ++j) { o[2 * j] *= bflo(g[j]); o[2 * j + 1] *= bfhi(g[j]); }
        if (!dry) *(u32x4*)yp = (u32x4){pk_bf16(o[0], o[1]), pk_bf16(o[2], o[3]), pk_bf16(o[4], o[5]), pk_bf16(o[6], o[7])};
    }
}
DEV void phase2(const Params& p, int l, char* smem, int dry = 0, int parts = 15) {
    char* ws = p.ws;
    const int nb = onb(), bid = obid();
    if (parts & 1) for (int it = bid; it < 512; it += nb) { asm volatile("" ::: "memory"); lora_item(p, l, it >> 1, it & 1, smem); }
    if (parts & 2) for (int j = bid; j < 2048; j += nb) {
        asm volatile("" ::: "memory");
        const int qb = j & 15, h = (j >> 4) & 3, b = j >> 6;
        const size_t t0 = (size_t)b * SEQ + qb * 128;
        attn_item<128, 128, false, 1>((const bf16_t*)(ws + OFF_XQ) + t0 * 512 + h * 128, 512,
                                      (const bf16_t*)(ws + OFF_XK) + (size_t)b * 256 * 512 + h * 128, 512, 128, nullptr, 0,
                                      (const bf16_t*)(ws + OFF_XVT) + ((size_t)b * 512 + h * 128) * 256, 256,
                                      4, 0, 0.08838834764831845f * 1.4426950408889634f, (bf16_t*)(ws + OFF_Y) + t0 * 2048 + 1536 + h * 128, 2048, smem, dry);
    }
    if (parts & 4) for (int it = bid; it < 2048; it += nb) { asm volatile("" ::: "memory"); conv_item(p, l, it, smem, dry); }
    if (!(parts & 8)) return;
    const int wid = otid() >> 6, lane = otid() & 63, li = lane & 15, tg = lane >> 4;
    const bf16_t* ql = (const bf16_t*)(ws + OFF_QL); const bf16_t* kvl = (const bf16_t*)(ws + OFF_KVL);
    float* rq = (float*)(ws + OFF_RQ); float* rkv = (float*)(ws + OFF_RKV);
    auto sq8 = [](u32x4 u) { float s = 0.f;
#pragma unroll
        for (int j = 0; j < 4; ++j) { const float a = bflo(u[j]), b = bfhi(u[j]); s += a * a + b * b; } return s; };
#pragma unroll 2
    for (int t = (bid * 8 + wid) * 4 + tg; t < T_TOK; t += nb * 32) {
        const u32x4* qp = (const u32x4*)(ql + (size_t)t * 384); const u32x4* kp = (const u32x4*)(kvl + (size_t)t * 256);
        const u32x4 q0 = qp[li], q1 = qp[li + 16], q2 = qp[li + 32], k0 = kp[li], k1 = kp[li + 16];
        float s = sq8(q0) + sq8(q1) + sq8(q2), s2 = sq8(k0) + sq8(k1);
        s += DPPF(s, 0xB1); s += DPPF(s, 0x4E); s += DPPF(s, 0x141); s += DPPF(s, 0x140);
        s2 += DPPF(s2, 0xB1); s2 += DPPF(s2, 0x4E); s2 += DPPF(s2, 0x141); s2 += DPPF(s2, 0x140);
        if (li == 0) { rq[t] = rsqrtf(s * (1.0f / 384.0f) + 1e-6f); rkv[t] = rsqrtf(s2 * (1.0f / 256.0f) + 1e-6f); }
    }
}

DEV void phase3(const Params& p, int l, char* smem, int dry = 0) {
    char* ws = p.ws;
    float* op = (float*)smem;
    float* ybuf = op + 2 * 32 * 384;
    float* bon = ybuf + 2 * 32 * 64;
    const bf16_t* rwp = (const bf16_t*)(ws + OFF_RWP);
    const bf16_t* ea = (const bf16_t*)(ws + OFF_EA);
    bf16_t* Y = (bf16_t*)(ws + OFF_Y);
    const int tid = otid();
    for (int chain = obid(); chain < 256; chain += onb()) {
        asm volatile("" ::: "memory");
        const int b = chain >> 3, h = chain & 7;
        __syncthreads();
        if (__builtin_amdgcn_readfirstlane(tid) >= 256) {
            const int pt = tid - 256, tok = pt >> 3, g = pt & 7, c0 = h * 64 + g * 8;
            float mur[8], muk[8], muv[8], kk_[8], ka_[8], rk_[8], lg[8], lb[8];
#pragma unroll
            for (int j = 0; j < 8; ++j) {
                mur[j] = p.rwkv_mu[l * 1664 + c0 + j]; muk[j] = p.rwkv_mu[l * 1664 + 512 + c0 + j]; muv[j] = p.rwkv_mu[l * 1664 + 1024 + c0 + j];
                kk_[j] = p.rwkv_k_k[l * 512 + c0 + j]; ka_[j] = p.rwkv_k_a[l * 512 + c0 + j]; rk_[j] = p.rwkv_r_k[l * 512 + c0 + j];
                lg[j] = p.rwkv_lnx_g[l * 512 + c0 + j]; lb[j] = p.rwkv_lnx_b[l * 512 + c0 + j];
            }
            auto prep = [&](int ci) {
                const int buf = ci & 1, s = ci * 32 + tok; const size_t t = (size_t)b * SEQ + s;
                const bf16_t* row = rwp + t * 1664 + c0;
                const u32x4 rc = *(const u32x4*)row, kc = *(const u32x4*)(row + 512), vc = *(const u32x4*)(row + 1024);
                u32x4 rp = (u32x4){0u, 0u, 0u, 0u}, kp = rp, vp = rp;
                if (s > 0) { rp = *(const u32x4*)(row - 1664); kp = *(const u32x4*)(row - 1664 + 512); vp = *(const u32x4*)(row - 1664 + 1024); }
                const u32x4 ee = *(const u32x4*)(ea + t * 1024 + c0), aa = *(const u32x4*)(ea + t * 1024 + 512 + c0);
                float r[8], k[8], v[8], kk[8], e[8], a[8];
#pragma unroll
                for (int j = 0; j < 4; ++j) {
                    float c, q;
                    c = bflo(rc[j]); q = bflo(rp[j]); r[2 * j] = c + mur[2 * j] * (q - c); c = bfhi(rc[j]); q = bfhi(rp[j]); r[2 * j + 1] = c + mur[2 * j + 1] * (q - c);
                    c = bflo(kc[j]); q = bflo(kp[j]); k[2 * j] = c + muk[2 * j] * (q - c); c = bfhi(kc[j]); q = bfhi(kp[j]); k[2 * j + 1] = c + muk[2 * j + 1] * (q - c);
                    c = bflo(vc[j]); q = bflo(vp[j]); v[2 * j] = c + muv[2 * j] * (q - c); c = bfhi(vc[j]); q = bfhi(vp[j]); v[2 * j + 1] = c + muv[2 * j + 1] * (q - c);
                    e[2 * j] = bflo(ee[j]); e[2 * j + 1] = bfhi(ee[j]); a[2 * j] = bflo(aa[j]); a[2 * j + 1] = bfhi(aa[j]);
                }
                float ss = 0.f;
#pragma unroll
                for (int j = 0; j < 8; ++j) { kk[j] = k[j] * kk_[j]; ss += kk[j] * kk[j]; }
                ss += __shfl_xor(ss, 1); ss += __shfl_xor(ss, 2); ss += __shfl_xor(ss, 4);
                const float inv = 1.0f / fmaxf(sqrtf(ss), 1e-12f);
                float* o = op + (size_t)(buf * 32 + tok) * 384 + g * 8;
                float bs = 0.f;
#pragma unroll
                for (int j = 0; j < 8; ++j) {
                    const float kn = kk[j] * inv, km = k[j] * (1.0f + (a[j] - 1.0f) * ka_[j]);
                    o[j] = -kn; o[64 + j] = __expf(-e[j]); o[128 + j] = kn * a[j]; o[192 + j] = km; o[256 + j] = r[j]; o[320 + j] = v[j];
                    bs += r[j] * km * rk_[j];
                }
                bs += __shfl_xor(bs, 1); bs += __shfl_xor(bs, 2); bs += __shfl_xor(bs, 4);
                if (g == 0) bon[buf * 32 + tok] = bs;
            };
            auto post = [&](int ci) {
                const int buf = ci & 1, s = ci * 32 + tok; const size_t t = (size_t)b * SEQ + s;
                const float* yb = ybuf + (buf * 32 + tok) * 64 + g * 8;
                float y[8]; float sm = 0.f;
#pragma unroll
                for (int j = 0; j < 8; ++j) { y[j] = yb[j]; sm += y[j]; }
                sm += __shfl_xor(sm, 1); sm += __shfl_xor(sm, 2); sm += __shfl_xor(sm, 4);
                const float mean = sm * (1.0f / 64.0f); float sq = 0.f;
#pragma unroll
                for (int j = 0; j < 8; ++j) { y[j] -= mean; sq += y[j] * y[j]; }
                sq += __shfl_xor(sq, 1); sq += __shfl_xor(sq, 2); sq += __shfl_xor(sq, 4);
                const float rstd = rsqrtf(sq * (1.0f / 64.0f) + 64e-5f);
                const float bo = bon[buf * 32 + tok];
                const float* vv = op + (size_t)(buf * 32 + tok) * 384 + 320 + g * 8;
                bf16_t* yp = Y + t * 2048 + c0;
                const u32x4 gg = *(const u32x4*)yp;
                float o[8];
#pragma unroll
                for (int j = 0; j < 8; ++j) o[j] = y[j] * rstd * lg[j] + lb[j] + bo * vv[j];
#pragma unroll
                for (int j = 0; j < 4; ++j) { o[2 * j] *= bflo(gg[j]); o[2 * j + 1] *= bfhi(gg[j]); }
                if (!dry) *(u32x4*)yp = (u32x4){pk_bf16(o[0], o[1]), pk_bf16(o[2], o[3]), pk_bf16(o[4], o[5]), pk_bf16(o[6], o[7])};
            };
            prep(0);
            __syncthreads();
            for (int ci = 0; ci < 64; ++ci) {
                if (ci >= 1) post(ci - 1);
                if (ci + 1 < 64) prep(ci + 1);
                __syncthreads();
            }
            post(63);
        } else {
            const int vp = tid >> 3, kq = tid & 7;
            f32x2 st[2][4];
#pragma unroll
            for (int i = 0; i < 2; ++i)
#pragma unroll
                for (int j = 0; j < 4; ++j) st[i][j] = (f32x2){0.f, 0.f};
            __syncthreads();
            for (int ci = 0; ci < 64; ++ci) {
                const int buf = ci & 1;
                const float* base0 = op + (size_t)buf * 32 * 384 + kq * 8;
                float* yb = ybuf + buf * 32 * 64 + 2 * vp;
#pragma unroll 8
                for (int tok = 0; tok < 32; ++tok) {
                    const float* bs = base0 + tok * 384;
                    const f32x4 a0 = *(const f32x4*)bs, a1 = *(const f32x4*)(bs + 4);
                    const f32x4 w0 = *(const f32x4*)(bs + 64), w1 = *(const f32x4*)(bs + 68);
                    const f32x4 b0 = *(const f32x4*)(bs + 128), b1 = *(const f32x4*)(bs + 132);
                    const f32x4 k0 = *(const f32x4*)(bs + 192), k1 = *(const f32x4*)(bs + 196);
                    const f32x4 r0 = *(const f32x4*)(bs + 256), r1 = *(const f32x4*)(bs + 260);
                    const f32x2 vv = *(const f32x2*)(op + (size_t)(buf * 32 + tok) * 384 + 320 + 2 * vp);
                    const f32x2 av[4] = {(f32x2){a0[0], a0[1]}, (f32x2){a0[2], a0[3]}, (f32x2){a1[0], a1[1]}, (f32x2){a1[2], a1[3]}};
                    const f32x2 wv[4] = {(f32x2){w0[0], w0[1]}, (f32x2){w0[2], w0[3]}, (f32x2){w1[0], w1[1]}, (f32x2){w1[2], w1[3]}};
                    const f32x2 bv[4] = {(f32x2){b0[0], b0[1]}, (f32x2){b0[2], b0[3]}, (f32x2){b1[0], b1[1]}, (f32x2){b1[2], b1[3]}};
                    const f32x2 kv[4] = {(f32x2){k0[0], k0[1]}, (f32x2){k0[2], k0[3]}, (f32x2){k1[0], k1[1]}, (f32x2){k1[2], k1[3]}};
                    const f32x2 rv[4] = {(f32x2){r0[0], r0[1]}, (f32x2){r0[2], r0[3]}, (f32x2){r1[0], r1[1]}, (f32x2){r1[2], r1[3]}};
                    float yo[2];
#pragma unroll
                    for (int i = 0; i < 2; ++i) {
                        f32x2 sa2 = st[i][0] * av[0]; sa2 += st[i][1] * av[1]; sa2 += st[i][2] * av[2]; sa2 += st[i][3] * av[3];
                        const float sa = reduce8_dpp(sa2[0] + sa2[1]);
                        const float vi = vv[i];
                        f32x2 y2 = (f32x2){0.f, 0.f};
#pragma unroll
                        for (int j = 0; j < 4; ++j) { st[i][j] = st[i][j] * wv[j] + sa * bv[j] + vi * kv[j]; y2 += st[i][j] * rv[j]; }
                        yo[i] = reduce8_dpp(y2[0] + y2[1]);
                    }
                    if (kq == 0) *(f32x2*)(yb + tok * 64) = (f32x2){yo[0], yo[1]};
                }
                __syncthreads();
            }
        }
    }
}

DEV void phase4(const Params& p, int l, char* smem) {
    WAVE_IDS
    char* ws = p.ws;
    const bf16_t* ql = (const bf16_t*)(ws + OFF_QL); const bf16_t* kvl = (const bf16_t*)(ws + OFF_KVL);
    const float* rq = (const float*)(ws + OFF_RQ); const float* rkv = (const float*)(ws + OFF_RKV);
    const float* cs = (const float*)(ws + OFF_CS);
    bf16_t* qb = (bf16_t*)(ws + OFF_QB); bf16_t* kn = (bf16_t*)(ws + OFF_KN); bf16_t* vtm = (bf16_t*)(ws + OFF_VTM);
    const bf16_t* wuq = (const bf16_t*)(ws + WOFF(WUQ, l)); const bf16_t* wuk = (const bf16_t*)(ws + WOFF(WUK, l)); const bf16_t* wuv = (const bf16_t*)(ws + WOFF(WUV, l));
    const int n_items = 768 + 512 + 512;
    for (int it = obid(); it < n_items; it += onb()) {
        asm volatile("" ::: "memory");
        f32x4 acc[4][8]; zero_acc8(acc);
        if (it < 768) {
            const int mt = it / 3, nt = it % 3, m0 = mt * 256, n0 = nt * 256 + wc * 128;
            gemm256(acc, ql, 384, m0, wuq, 384, nt * 256, 384, smem);
#pragma unroll
            for (int mi = 0; mi < 4; ++mi) { const size_t row = m0 + wr * 64 + mi * 16 + fr; const float rs = rq[row];
                const f32x4 c = *(const f32x4*)(cs + row * 32 + fq * 4), s = *(const f32x4*)(cs + row * 32 + 16 + fq * 4);
#pragma unroll
                for (int ni = 0; ni < 8; ++ni) acc[mi][ni] *= rs;
#pragma unroll
                for (int pp = 0; pp < 4; ++pp) { const int cs0 = n0 + pp * 32; if ((cs0 % 96) == 64) { const f32x4 x1 = acc[mi][2 * pp], x2 = acc[mi][2 * pp + 1]; acc[mi][2 * pp] = x1 * c - x2 * s; acc[mi][2 * pp + 1] = x1 * s + x2 * c; } }
#pragma unroll
                for (int ni = 0; ni < 8; ++ni) store4(qb + row * 768 + n0 + ni * 16 + fq * 4, acc[mi][ni]); }
        } else if (it < 1280) {
            const int j = it - 768, mt = j >> 1, nt = j & 1, m0 = mt * 256, n0 = nt * 256 + wc * 128;
            gemm256(acc, kvl, 256, m0, wuk, 256, nt * 256, 256, smem);
#pragma unroll
            for (int mi = 0; mi < 4; ++mi) { const size_t row = m0 + wr * 64 + mi * 16 + fr; const float rs = rkv[row];
#pragma unroll
                for (int ni = 0; ni < 8; ++ni) store4(kn + row * 512 + n0 + ni * 16 + fq * 4, acc[mi][ni] * rs); }
        } else {
            const int j = it - 1280, b = j >> 4, mt = (j >> 3) & 1, nt = j & 7, m0 = mt * 256, n0 = nt * 256 + wc * 128;
            gemm256(acc, wuv, 256, m0, kvl + (size_t)b * SEQ * 256, 256, nt * 256, 256, smem);
#pragma unroll
            for (int ni = 0; ni < 8; ++ni) { const int col = n0 + ni * 16 + fq * 4; const f32x4 rs = *(const f32x4*)(rkv + (size_t)b * SEQ + col);
#pragma unroll
                for (int mi = 0; mi < 4; ++mi) { const size_t row = m0 + wr * 64 + mi * 16 + fr; store4(vtm + ((size_t)b * 512 + row) * SEQ + col, acc[mi][ni] * rs); } }
        }
    }
}

DEV void phase5(const Params& p, char* smem, int dry = 0) {
    char* ws = p.ws;
    for (int it = obid(); it < 2048; it += onb()) {
        asm volatile("" ::: "memory");
        const int bh = it & 255, qb = 7 - (it >> 8), b = bh >> 3, h = bh & 7;
        const size_t t0 = (size_t)b * SEQ + qb * 256;
        __syncthreads();
        attn_item<96, 64, true, 2>((const bf16_t*)(ws + OFF_QB) + t0 * 768 + h * 96, 768,
                                (const bf16_t*)(ws + OFF_KN) + (size_t)b * SEQ * 512 + h * 64, 512, 64,
                                (const bf16_t*)(ws + OFF_KPE) + (size_t)b * SEQ * 32, 32,
                                (const bf16_t*)(ws + OFF_VTM) + ((size_t)b * 512 + h * 64) * SEQ, SEQ,
                                (qb + 1) * 4, qb * 256, 0.10206207261596577f * 1.4426950408889634f, (bf16_t*)(ws + OFF_Y) + t0 * 2048 + 512 + h * 64, 2048, smem, dry);
    }
}

DEV void phase6(const Params& p, int l, char* smem) {
    WAVE_IDS
    char* ws = p.ws;
    const bf16_t* xb = l == 0 ? (const bf16_t*)p.out : (const bf16_t*)(ws + OFF_XB1);
    const bf16_t* wm = (const bf16_t*)(ws + WOFF(WM, l)); const bf16_t* wo = (const bf16_t*)(ws + WOFF(WO, l));
    const bf16_t* Y = (const bf16_t*)(ws + OFF_Y); bf16_t* mg = (bf16_t*)(ws + OFF_MG);
    bool first_gemm = true;
    for (int it = obid(); it < 256 * 8; it += onb()) {
        asm volatile("" ::: "memory");
        const int xcd = it & 7, w = it >> 3, mt = xcd * 32 + (w >> 5) * 4 + ((w & 31) >> 3), nt = w & 7, m0 = mt * 256, n0 = nt * 128;
        f32x4 mrg[4][4]; zero_acc<4>(mrg);
        for (int n = 0; n < 4; ++n) {
            u32x2 gpk[4][4];
            {
                f32x4 ag[4][4]; zero_acc<4>(ag);
                if (first_gemm) { gemm_mainloop<4, 1, 1>(ag, xb, 1024, m0, wm + (size_t)n * 1024 * 1024, 1024, n0, 1024, smem, ((w & 7) * 2 + ((w >> 3) & 1)) & 15); first_gemm = false; }
                else gemm_mainloop<4, 1, 0>(ag, xb, 1024, m0, wm + (size_t)n * 1024 * 1024, 1024, n0, 1024, smem, ((w & 7) * 2 + ((w >> 3) & 1)) & 15);
#pragma unroll
                for (int ni = 0; ni < 4; ++ni) { const f32x4 bz = *(const f32x4*)(p.b_gate + ((size_t)l * 4 + n) * 1024 + n0 + wc * 64 + ni * 16 + fq * 4);
#pragma unroll
                    for (int mi = 0; mi < 4; ++mi) { const f32x4 v = ag[mi][ni] + bz; gpk[mi][ni] = (u32x2){pk_bf16(sigmoidf_(v[0]), sigmoidf_(v[1])), pk_bf16(sigmoidf_(v[2]), sigmoidf_(v[3]))}; } }
            }
            f32x4 ap[4][4]; zero_acc<4>(ap);
            gemm_mainloop<4, 0, 0>(ap, Y + n * 512, 2048, m0, wo + (size_t)n * 1024 * 512, 512, n0, 512, smem, w & 7);
#pragma unroll
            for (int mi = 0; mi < 4; ++mi)
#pragma unroll
                for (int ni = 0; ni < 4; ++ni) { const u32x2 g = gpk[mi][ni]; mrg[mi][ni] += (f32x4){bflo(g[0]), bfhi(g[0]), bflo(g[1]), bfhi(g[1])} * ap[mi][ni]; }
        }
        epi_plain<4>(mrg, mg, 1024, m0, n0, wr, wc, fr, fq);
    }
}
DEV void phase7(const Params& p, int l, char* smem) {
    WAVE_IDS
    char* ws = p.ws;
    const bf16_t* mg = (const bf16_t*)(ws + OFF_MG); const bf16_t* wout = (const bf16_t*)(ws + WOFF(WOUT, l)); bf16_t* o = (bf16_t*)(ws + OFF_OUT);
    for (int it = obid(); it < 256 * 4; it += onb()) {
        asm volatile("" ::: "memory");
        const int xcd = it & 7, w = it >> 3, mt = xcd * 32 + (w >> 2), nt = w & 3;
        f32x4 acc[4][8]; zero_acc8(acc);
        gemm256(acc, mg, 1024, mt * 256, wout, 1024, nt * 256, 1024, smem, ((w & 3) * 8 + ((w >> 2) & 7)) & 31);
        epi_plain8(acc, o, 1024, mt * 256, nt * 256, wr, wc, fr, fq, smem);
    }
}
DEV void phase8(const Params& p, int l) {
    char* ws = p.ws;
    const float* xin = l == 0 ? p.x : p.out; const bf16_t* o = (const bf16_t*)(ws + OFF_OUT);
    const int wid = otid() >> 6, lane = otid() & 63;
    const float alpha = 1.4142135623730951f;
    for (int t = obid() * 8 + wid; t < T_TOK; t += onb() * 8) {
        f32x4 v[4]; float sm = 0.f;
#pragma unroll
        for (int j = 0; j < 4; ++j) { const int col = j * 256 + lane * 4; const f32x4 xv = *(const f32x4*)(xin + (size_t)t * 1024 + col); const u32x2 ov = *(const u32x2*)(o + (size_t)t * 1024 + col);
            v[j] = xv * alpha + (f32x4){bflo(ov[0]), bfhi(ov[0]), bflo(ov[1]), bfhi(ov[1])}; sm += (v[j][0] + v[j][1]) + (v[j][2] + v[j][3]); }
        const float mean = wave_sum(sm) * (1.0f / 1024.0f); float sq = 0.f;
#pragma unroll
        for (int j = 0; j < 4; ++j) { v[j] -= mean; sq += (v[j][0] * v[j][0] + v[j][1] * v[j][1]) + (v[j][2] * v[j][2] + v[j][3] * v[j][3]); }
        const float rstd = rsqrtf(wave_sum(sq) * (1.0f / 1024.0f) + 1e-5f);
#pragma unroll
        for (int j = 0; j < 4; ++j) { const int col = j * 256 + lane * 4; const f32x4 g = *(const f32x4*)(p.ln_g + l * 1024 + col), bb = *(const f32x4*)(p.ln_b + l * 1024 + col);
            const f32x4 ov = v[j] * rstd * g + bb;
            *(f32x4*)(p.out + (size_t)t * 1024 + col) = ov;
            if (l == 0) store4((bf16_t*)(ws + OFF_XB1) + (size_t)t * 1024 + col, ov); }
    }
}

#ifndef REP_PH
#define REP_PH 0
#endif
#ifndef PHMASK
#define PHMASK 0x1ff
#endif

#define XB_TMO      128
#define XB_XCNT(j)  (256  + 64 * (j))
#define XB_XSUB(j)  (1280 + 64 * (j))
#define XB_XGEN(j)  (2304 + 64 * (j))
#define XB_TOP      3328
#define XB_TOPGEN   3392
#define XCD_BAR_WORDS 3456
#define XB_SPIN_CAP (1u << 18)
#define LAS __attribute__((address_space(3)))
DEV unsigned xb_ld(unsigned* p)              { return __hip_atomic_load(p, __ATOMIC_RELAXED, __HIP_MEMORY_SCOPE_AGENT); }
DEV unsigned xb_add(unsigned* p, unsigned v) { return __hip_atomic_fetch_add(p, v, __ATOMIC_RELAXED, __HIP_MEMORY_SCOPE_AGENT); }
DEV unsigned xb_xcc_id() { return (unsigned)__builtin_amdgcn_s_getreg((3 << 11) | 20) & 0xFu; }
#define XB_SPIN(cond, bar) do { unsigned _sp = 0; while (cond) { __builtin_amdgcn_s_sleep(1); \
    if ((++_sp & 255u) == 0u) { if (xb_ld(&(bar)[XB_TMO])) break; if (_sp > XB_SPIN_CAP) { atomicAdd(&(bar)[XB_TMO], 1u); break; } } } } while (0)
struct XcdBarrier { unsigned* bar; unsigned x; volatile LAS unsigned* st; };
DEV XcdBarrier xcd_barrier_post(unsigned* bar, volatile LAS unsigned* st) {
    XcdBarrier b; b.bar = bar; b.x = xb_xcc_id(); b.st = st;
    if (threadIdx.x == 0) st[3] = xb_add(&bar[XB_XCNT(b.x)], 1u);
    return b;
}
DEV void xcd_barrier_complete(unsigned* bar, unsigned x, unsigned& nloc, unsigned& nx) {
    const unsigned G = gridDim.x * gridDim.y * gridDim.z;
    unsigned sum, cnt, mine, sp = 0u;
    for (;;) {
        sum = 0u; cnt = 0u; mine = 0u;
#pragma unroll
        for (unsigned j = 0; j < 16; ++j) { const unsigned c = xb_ld(&bar[XB_XCNT(j)]); sum += c; cnt += (c > 0u) ? 1u : 0u; mine = (j == x) ? c : mine; }
        if (sum == G) break;
        __builtin_amdgcn_s_sleep(1);
        if ((++sp & 255u) == 0u) { if (xb_ld(&bar[XB_TMO])) break; if (sp > XB_SPIN_CAP) { atomicAdd(&bar[XB_TMO], 1u); break; } }
    }
    nloc = mine > 0u ? mine : 1u; nx = cnt > 0u ? cnt : 1u;
}
DEV void xcd_barrier(const XcdBarrier& b) {
    asm volatile("s_waitcnt vmcnt(0)" ::: "memory");
    __syncthreads();
    if (threadIdx.x == 0) {
        unsigned* bar = b.bar;
        __builtin_amdgcn_s_waitcnt(0);
        unsigned nloc = b.st[0], nx = b.st[1];
        if (nloc == 0u) { xcd_barrier_complete(bar, b.x, nloc, nx); b.st[0] = nloc; b.st[1] = nx; }
        const unsigned old = xb_add(&bar[XB_XSUB(b.x)], 1u);
        const unsigned gen = old / nloc;
        if (old + 1u == (gen + 1u) * nloc) {
            __builtin_amdgcn_fence(__ATOMIC_RELEASE, "agent");
            asm volatile("s_waitcnt vmcnt(0)" ::: "memory");
            const unsigned og = xb_add(&bar[XB_TOP], 1u);
            const unsigned tg = og / nx;
            if (og + 1u == (tg + 1u) * nx) xb_add(&bar[XB_TOPGEN], 1u);
            else XB_SPIN(xb_ld(&bar[XB_TOPGEN]) == tg, bar);
            __builtin_amdgcn_fence(__ATOMIC_ACQUIRE, "agent");
            xb_add(&bar[XB_XGEN(b.x)], 1u);
            asm volatile("s_waitcnt vmcnt(0)" ::: "memory");
        } else {
            XB_SPIN(xb_ld(&bar[XB_XGEN(b.x)]) == gen, bar);
            __builtin_amdgcn_fence(__ATOMIC_ACQUIRE, "agent");
            asm volatile("s_waitcnt vmcnt(0)" ::: "memory");
        }
    }
    __syncthreads();
}
constexpr size_t OFF_BAR = ((WS_END + 4095) / 4096) * 4096;
#define GSYNC_CG() do { asm volatile("s_waitcnt vmcnt(0) lgkmcnt(0)" ::: "memory"); grid.sync(); } while (0)
#define GSYNC() xcd_barrier(xb)
typedef const __attribute__((address_space(4))) Params* KParams;
DEV Params load_params() {
#if defined(__HIP_DEVICE_COMPILE__)
    auto k = __builtin_amdgcn_kernarg_segment_ptr();
    asm volatile("" : "+s"(k) :: "memory");
    return *(KParams)k;
#else
    return Params{};
#endif
}
__global__ void __launch_bounds__(NTHR) mega_fwd(Params p_unused) {
    char* smem = smem_g;
    cg::grid_group grid = cg::this_grid();
    XcdBarrier xb;
    {
        volatile LAS unsigned* st = (volatile LAS unsigned*)(smem + LDS_MAIN);
        if (threadIdx.x == 0) { st[0] = 0u; st[1] = 0u; st[2] = blockIdx.x; st[3] = 0u; }
        __syncthreads();
        const Params p = load_params();
        xb = xcd_barrier_post((unsigned*)(p.ws + OFF_BAR), st);
    }
    if (PHMASK & 1) { const Params p = load_params(); phase_prologue(p, smem); }
    GSYNC_CG();
    {
        if (threadIdx.x == 0) {
            const unsigned G = gridDim.x; bool ok = (G % 8u) == 0u;
            for (unsigned j = 0; j < 16; ++j) { const unsigned c = xb_ld(&xb.bar[XB_XCNT(j)]); ok = ok && (c == (j < 8u ? G / 8u : 0u)); }
            if (ok) xb.st[2] = xb.st[3] * 8u + xb.x;
        }
        __syncthreads();
    }
    if (REP_PH == 9) { const Params p = load_params(); phase_prologue(p, smem); GSYNC(); }
    if (REP_PH == 10) { for (int q = 0; q < 20; ++q) GSYNC(); }
    for (int l = 0; l < 2; ++l) {
        if (PHMASK & 2) { const Params p = load_params(); phase1(p, l, smem); } GSYNC();
        if (REP_PH == 1) { const Params p = load_params(); int dry = 1; asm volatile("" : "+s"(dry)); phase1(p, l, smem); GSYNC(); }
        if (PHMASK & 4) { const Params p = load_params(); phase2(p, l, smem); } GSYNC();
        if (REP_PH == 2) { const Params p = load_params(); int dry = 1; asm volatile("" : "+s"(dry)); phase2(p, l, smem, dry); GSYNC(); }
        if (REP_PH >= 31 && REP_PH <= 34) { const Params p = load_params(); int dry = 1, parts = 1 << (REP_PH - 31); asm volatile("" : "+s"(dry), "+s"(parts)); phase2(p, l, smem, dry, parts); GSYNC(); }
        if (PHMASK & 8) { const Params p = load_params(); phase3(p, l, smem); } GSYNC();
        if (REP_PH == 3) { const Params p = load_params(); int dry = 1; asm volatile("" : "+s"(dry)); phase3(p, l, smem, dry); GSYNC(); }
        if (PHMASK & 16) { const Params p = load_params(); phase4(p, l, smem); } GSYNC();
        if (REP_PH == 4) { const Params p = load_params(); int dry = 1; asm volatile("" : "+s"(dry)); phase4(p, l, smem); GSYNC(); }
        if (PHMASK & 32) { const Params p = load_params(); phase5(p, smem); } GSYNC();
        if (REP_PH == 5) { const Params p = load_params(); int dry = 1; asm volatile("" : "+s"(dry)); phase5(p, smem, dry); GSYNC(); }
        if (PHMASK & 64) { const Params p = load_params(); phase6(p, l, smem); } GSYNC();
        if (REP_PH == 6) { const Params p = load_params(); int dry = 1; asm volatile("" : "+s"(dry)); phase6(p, l, smem); GSYNC(); }
        if (PHMASK & 128) { const Params p = load_params(); phase7(p, l, smem); } GSYNC();
        if (REP_PH == 7) { const Params p = load_params(); int dry = 1; asm volatile("" : "+s"(dry)); phase7(p, l, smem); GSYNC(); }
        if (PHMASK & 256) { const Params p = load_params(); phase8(p, l); }
        if (l == 0) GSYNC();
    }
}

extern "C" void kernel_launch(void* const* d_in, const int* in_sizes, int n_in, void* d_out, int out_size, void* d_ws, size_t ws_size, hipStream_t stream) {
    static int grid_blocks = 0;
    if (grid_blocks == 0) {
        if (n_in != 28 || ws_size < OFF_BAR + XCD_BAR_WORDS * 4) { fprintf(stderr, "kernel_launch: unexpected n_in %d or ws %zu (< %zu)\n", n_in, ws_size, (size_t)WS_END); grid_blocks = -1; return; }
        int dev = 0, cus = 0, per_cu = 0;
        hipGetDevice(&dev);
        hipDeviceGetAttribute(&cus, hipDeviceAttributeMultiprocessorCount, dev);
        if (hipFuncSetAttribute((const void*)mega_fwd, hipFuncAttributeMaxDynamicSharedMemorySize, LDS_BYTES) != hipSuccess) { fprintf(stderr, "hipFuncSetAttribute failed\n"); grid_blocks = -1; return; }
        hipOccupancyMaxActiveBlocksPerMultiprocessor(&per_cu, (const void*)mega_fwd, NTHR, LDS_BYTES);
        if (per_cu < 1) { fprintf(stderr, "occupancy query returned %d\n", per_cu); grid_blocks = -1; return; }
        grid_blocks = cus * 1;
    }
    if (grid_blocks < 0) return;
    Params p{};
    p.x = (const float*)d_in[0]; p.mem = (const float*)d_in[1]; p.pos = (const int*)d_in[2]; p.w_in = (const float*)d_in[3]; p.b_gate = (const float*)d_in[4];
    p.rwkv_mu = (const float*)d_in[5]; p.rwkv_w0 = (const float*)d_in[6]; p.rwkv_w2 = (const float*)d_in[7]; p.rwkv_a0 = (const float*)d_in[8]; p.rwkv_a2 = (const float*)d_in[9];
    p.rwkv_k_k = (const float*)d_in[10]; p.rwkv_k_a = (const float*)d_in[11]; p.rwkv_r_k = (const float*)d_in[12]; p.rwkv_lnx_g = (const float*)d_in[13]; p.rwkv_lnx_b = (const float*)d_in[14];
    p.mla_q_norm = (const float*)d_in[15]; p.mla_w_uq = (const float*)d_in[16]; p.mla_kv_norm = (const float*)d_in[17]; p.mla_w_ukv = (const float*)d_in[18];
    p.conv_w = (const float*)d_in[19]; p.conv_b = (const float*)d_in[20]; p.conv_ln_g = (const float*)d_in[21]; p.conv_ln_b = (const float*)d_in[22];
    p.xattn_w = (const float*)d_in[23]; p.w_o_branch = (const float*)d_in[24]; p.w_out = (const float*)d_in[25]; p.ln_g = (const float*)d_in[26]; p.ln_b = (const float*)d_in[27];
    p.out = (float*)d_out; p.ws = (char*)d_ws;
    if (hipMemsetAsync((char*)d_ws + OFF_BAR, 0, XCD_BAR_WORDS * 4, stream) != hipSuccess) { fprintf(stderr, "memset failed\n"); return; }
    void* args[] = {&p};
    hipError_t e = hipLaunchCooperativeKernel((const void*)mega_fwd, dim3(grid_blocks), dim3(NTHR), args, LDS_BYTES, stream);
    if (e != hipSuccess) fprintf(stderr, "cooperative launch failed: %s (grid %d)\n", hipGetErrorString(e), grid_blocks);
}
```

```cpp
#include <hip/hip_runtime.h>
#include <hip/hip_cooperative_groups.h>
#include <cstdio>
#include <cstdint>
#include <cmath>
namespace cg = cooperative_groups;

typedef unsigned short bf16_t;
typedef short bf16x8 __attribute__((ext_vector_type(8)));
typedef float f32x4 __attribute__((ext_vector_type(4)));
typedef float f32x2 __attribute__((ext_vector_type(2)));
typedef unsigned u32x4 __attribute__((ext_vector_type(4)));
typedef unsigned u32x2 __attribute__((ext_vector_type(2)));

#define DEV __device__ __forceinline__

constexpr int NTHR = 512;
constexpr int T_TOK = 65536;
constexpr int SEQ = 2048;
constexpr int DM = 1024;
constexpr int IN_COLS = 10016;
constexpr int NH = 6016;
constexpr int NHP = 6144;
constexpr int LDS_MAIN = 147456;
constexpr int LDS_BYTES = LDS_MAIN + 16;
constexpr int LDSK = 80;

constexpr size_t sz_WIN = (size_t)NHP * 1024 * 2, sz_WM = (size_t)4096 * 1024 * 2, sz_WKVX = (size_t)1024 * 1024 * 2;
constexpr size_t sz_WUQ = (size_t)768 * 384 * 2, sz_WUK = (size_t)512 * 256 * 2, sz_WO = (size_t)4 * 1024 * 512 * 2, sz_WOUT = (size_t)1024 * 1024 * 2;
constexpr size_t sz_LORA = (size_t)512 * 64 * 2;
constexpr size_t R_WIN = 0, R_WM = R_WIN + sz_WIN, R_WKVX = R_WM + sz_WM, R_WUQ = R_WKVX + sz_WKVX, R_WUK = R_WUQ + sz_WUQ, R_WUV = R_WUK + sz_WUK;
constexpr size_t R_WO = R_WUV + sz_WUK, R_WOUT = R_WO + sz_WO, R_W2 = R_WOUT + sz_WOUT, R_A2 = R_W2 + sz_LORA, SZ_LW = ((R_A2 + sz_LORA + 4095) / 4096) * 4096;
constexpr size_t OFF_L1W = 0;
constexpr size_t OFF_MEMB = OFF_L1W + SZ_LW;
constexpr size_t OFF_CS = OFF_MEMB + (size_t)8192 * 1024 * 2;
constexpr size_t OFF_XK = OFF_CS + (size_t)T_TOK * 32 * 4;
constexpr size_t OFF_XVT = OFF_XK + (size_t)8192 * 512 * 2;
constexpr size_t OFF_RQ = OFF_XVT + (size_t)8192 * 512 * 2;
constexpr size_t OFF_RKV = OFF_RQ + (size_t)T_TOK * 4;
constexpr size_t OFF_Y = ((OFF_RKV + (size_t)T_TOK * 4 + 4095) / 4096) * 4096;
constexpr size_t OFF_QL = OFF_Y + (size_t)T_TOK * 2048 * 2;
constexpr size_t OFF_KVL = OFF_QL + (size_t)T_TOK * 384 * 2;
constexpr size_t OFF_KPE = OFF_KVL + (size_t)T_TOK * 256 * 2;
constexpr size_t OFF_CU = OFF_KPE + (size_t)T_TOK * 32 * 2;
constexpr size_t OFF_XQ = OFF_CU + (size_t)T_TOK * 512 * 2;
constexpr size_t OFF_RWP = OFF_XQ + (size_t)T_TOK * 512 * 2;
constexpr size_t OFF_EA = OFF_RWP + (size_t)T_TOK * 1664 * 2;
constexpr size_t OFF_XB1 = OFF_EA + (size_t)T_TOK * 1024 * 2;
constexpr size_t OFF_L0W = OFF_XB1 + (size_t)T_TOK * 1024 * 2 - SZ_LW;
constexpr size_t WS_END = OFF_XB1 + (size_t)T_TOK * 1024 * 2;
#define WOFF(NAME, l) (((l) == 0 ? OFF_L0W : OFF_L1W) + R_##NAME)
constexpr size_t OFF_MG = OFF_CU;
constexpr size_t OFF_QB = OFF_RWP;
constexpr size_t OFF_KN = OFF_QB + (size_t)T_TOK * 768 * 2;
constexpr size_t OFF_VTM = OFF_KN + (size_t)T_TOK * 512 * 2;
constexpr size_t OFF_OUT = OFF_RWP;
static_assert(OFF_VTM + (size_t)T_TOK * 512 * 2 <= OFF_XB1, "alias overflow");
static_assert(WS_END <= ((size_t)1 << 30), "workspace overflow");

struct Params {
    const float* x; const float* mem; const int* pos; const float* w_in; const float* b_gate; const float* rwkv_mu; const float* rwkv_w0;
    const float* rwkv_w2; const float* rwkv_a0; const float* rwkv_a2; const float* rwkv_k_k; const float* rwkv_k_a; const float* rwkv_r_k;
    const float* rwkv_lnx_g; const float* rwkv_lnx_b; const float* mla_q_norm; const float* mla_w_uq; const float* mla_kv_norm; const float* mla_w_ukv;
    const float* conv_w; const float* conv_b; const float* conv_ln_g; const float* conv_ln_b; const float* xattn_w; const float* w_o_branch;
    const float* w_out; const float* ln_g; const float* ln_b;
    float* out; char* ws;
};

typedef __bf16 bf16x2_t __attribute__((ext_vector_type(2)));
DEV unsigned pk_bf16(float lo, float hi) { const bf16x2_t v = __builtin_convertvector((f32x2){lo, hi}, bf16x2_t); return __builtin_bit_cast(unsigned, v); }
DEV bf16_t f2bf(float f) { return (bf16_t)(pk_bf16(f, 0.f) & 0xffffu); }
DEV float bflo(unsigned u) { return __uint_as_float(u << 16); }
DEV float bfhi(unsigned u) { return __uint_as_float(u & 0xffff0000u); }
DEV float bf2f(bf16_t h) { return __uint_as_float(((unsigned)h) << 16); }
DEV int otid() { int t = threadIdx.x; asm volatile("" : "+v"(t)); return t; }
extern __shared__ __attribute__((aligned(16))) char smem_g[];
DEV int obid() { int t = __builtin_amdgcn_readfirstlane(*(volatile int*)(smem_g + 147456 + 8)); asm volatile("" : "+s"(t)); return t; }
DEV int onb() { int t = gridDim.x; asm volatile("" : "+s"(t)); return t; }
DEV float sigmoidf_(float v) { return __builtin_amdgcn_rcpf(1.0f + __expf(-v)); }
DEV float siluf_(float v) { return v * __builtin_amdgcn_rcpf(1.0f + __expf(-v)); }
#define DPPF(v, ctrl) __builtin_bit_cast(float, __builtin_amdgcn_update_dpp(0, __builtin_bit_cast(int, (v)), (ctrl), 0xF, 0xF, true))
DEV float reduce8_dpp(float v) { v += DPPF(v, 0xB1); v += DPPF(v, 0x4E); v += DPPF(v, 0x141); return v; }
DEV float wave_sum(float v) {
#pragma unroll
    for (int o = 32; o >= 1; o >>= 1) v += __shfl_xor(v, o);
    return v;
}

template <int MI> DEV void mma_ktile(f32x4 (&acc)[MI][4], const bf16_t* sA, const bf16_t* sB, int wr, int wc, int fr, int fq) {
#pragma unroll
    for (int ks = 0; ks < 2; ++ks) {
        bf16x8 af[MI], bfr[4];
#pragma unroll
        for (int mi = 0; mi < MI; ++mi) af[mi] = *(const bf16x8*)(sA + (wr * 16 * MI + mi * 16 + fr) * LDSK + ks * 32 + fq * 8);
#pragma unroll
        for (int ni = 0; ni < 4; ++ni) bfr[ni] = *(const bf16x8*)(sB + (wc * 64 + ni * 16 + fr) * LDSK + ks * 32 + fq * 8);
#pragma unroll
        for (int mi = 0; mi < MI; ++mi)
#pragma unroll
            for (int ni = 0; ni < 4; ++ni) acc[mi][ni] = __builtin_amdgcn_mfma_f32_16x16x32_bf16(bfr[ni], af[mi], acc[mi][ni], 0, 0, 0);
    }
}

DEV void stage_rc(int b, int& R, int& C) { const int st = b >> 10, sb = b & 1023, swz = sb ^ (((sb >> 9) & 1) << 5); R = (st >> 1) * 16 + (swz >> 6); C = (st & 1) * 32 + ((swz & 63) >> 1); }
DEV void glds16(const bf16_t* g, char* l) { __builtin_amdgcn_global_load_lds((const unsigned*)g, (__attribute__((address_space(3))) unsigned*)l, 16, 0, 0); }
template <int MI, int PIPE = 1, int SYNC = 1>
DEV void gemm_mainloop(f32x4 (&acc)[MI][4], const bf16_t* A, int lda, int m0, const bf16_t* Bt, int ldb, int n0, int K, char* smem, int rot = 0) {
    constexpr int NHA = MI / 2, STG = (NHA + 1) * 16384;
    const int tid = otid(), wid = tid >> 6, lane = tid & 63, wr = wid >> 1, wc = wid & 1, fr = lane & 15, fq = lane >> 4;
    int R0, C0, R1, C1; stage_rc(tid * 16, R0, C0); stage_rc(tid * 16 + 8192, R1, C1);
    const bf16_t* gA0 = A + (size_t)(m0 + R0) * lda + C0; const bf16_t* gA1 = A + (size_t)(m0 + R1) * lda + C1;
    const bf16_t* gB0 = Bt + (size_t)(n0 + R0) * ldb + C0; const bf16_t* gB1 = Bt + (size_t)(n0 + R1) * ldb + C1;
    char* l0 = smem + tid * 16;
    const int sw = (fr * 64 + fq * 16) ^ ((fr >> 3) << 5);
    const char* rdA = smem + (wr * MI) * 2048 + sw;
    const char* rdB = smem + NHA * 16384 + (wc * 4) * 2048 + sw;
    const int nk = K / 64;
#define STAGE(stg, kt) do { char* _l = l0 + (stg) * STG; int _k = (kt) + rot; _k = _k >= nk ? _k - nk : _k; _k *= 64; \
        _Pragma("unroll") for (int h = 0; h < NHA; ++h) { glds16(gA0 + (size_t)h * 128 * lda + _k, _l + h * 16384); glds16(gA1 + (size_t)h * 128 * lda + _k, _l + h * 16384 + 8192); } \
        glds16(gB0 + _k, _l + NHA * 16384); glds16(gB1 + _k, _l + NHA * 16384 + 8192); } while (0)
#define WAITV_TILE() do { if constexpr (MI == 4) asm volatile("s_waitcnt vmcnt(6)" ::: "memory"); else asm volatile("s_waitcnt vmcnt(4)" ::: "memory"); } while (0)
    if constexpr (SYNC) __syncthreads();
    STAGE(0, 0); STAGE(1, 1); STAGE(2, 2);
    if constexpr (MI == 4) asm volatile("s_waitcnt vmcnt(12)" ::: "memory"); else asm volatile("s_waitcnt vmcnt(8)" ::: "memory");
    __builtin_amdgcn_s_barrier();
    asm volatile("" ::: "memory");
    int stg = 0;
    for (int kt = 0; kt < nk; ++kt) {
        const char* pa = rdA + stg * STG; const char* pb = rdB + stg * STG;
        bf16x8 af[2][MI], bfr[2][4];
#pragma unroll
        for (int mi = 0; mi < MI; ++mi) af[0][mi] = *(const bf16x8*)(pa + mi * 2048);
#pragma unroll
        for (int ni = 0; ni < 4; ++ni) bfr[0][ni] = *(const bf16x8*)(pb + ni * 2048);
        if constexpr (PIPE) {
#pragma unroll
            for (int mi = 0; mi < MI; ++mi) af[1][mi] = *(const bf16x8*)(pa + mi * 2048 + 1024);
#pragma unroll
            for (int ni = 0; ni < 4; ++ni) bfr[1][ni] = *(const bf16x8*)(pb + ni * 2048 + 1024);
            __builtin_amdgcn_sched_barrier(0);
        }
        __builtin_amdgcn_s_setprio(1);
#pragma unroll
        for (int mi = 0; mi < MI; ++mi)
#pragma unroll
            for (int ni = 0; ni < 4; ++ni) acc[mi][ni] = __builtin_amdgcn_mfma_f32_16x16x32_bf16(bfr[0][ni], af[0][mi], acc[mi][ni], 0, 0, 0);
        if constexpr (!PIPE) {
#pragma unroll
            for (int mi = 0; mi < MI; ++mi) af[1][mi] = *(const bf16x8*)(pa + mi * 2048 + 1024);
#pragma unroll
            for (int ni = 0; ni < 4; ++ni) bfr[1][ni] = *(const bf16x8*)(pb + ni * 2048 + 1024);
        }
        __builtin_amdgcn_sched_barrier(0);
        if (kt + 2 < nk) WAITV_TILE(); else asm volatile("s_waitcnt vmcnt(0)" ::: "memory");
        asm volatile("s_waitcnt lgkmcnt(0)" ::: "memory");
        __builtin_amdgcn_s_barrier();
        asm volatile("" ::: "memory");
        if (kt + 3 < nk) STAGE(stg, kt + 3);
        __builtin_amdgcn_sched_barrier(0);
#pragma unroll
        for (int mi = 0; mi < MI; ++mi)
#pragma unroll
            for (int ni = 0; ni < 4; ++ni) acc[mi][ni] = __builtin_amdgcn_mfma_f32_16x16x32_bf16(bfr[1][ni], af[1][mi], acc[mi][ni], 0, 0, 0);
        __builtin_amdgcn_s_setprio(0);
        stg = stg == 2 ? 0 : stg + 1;
    }
#undef STAGE
#undef WAITV_TILE
}

DEV void gemm256(f32x4 (&acc)[4][8], const bf16_t* A, int lda, int m0, const bf16_t* Bt, int ldb, int n0, int K, char* smem, int rot = 0) {
    const int tid = otid(), wid = tid >> 6, lane = tid & 63, wr = wid >> 1, wc = wid & 1, fr = lane & 15, fq = lane >> 4;
    int R, C; { const int b = tid * 16, st = b >> 10, sb = b & 1023, swz = sb ^ (((sb >> 9) & 1) << 5); R = st * 16 + (swz >> 6); C = (swz & 63) >> 1; }
    const bf16_t* gA = A + (size_t)(m0 + R) * lda + C;
    const bf16_t* gB = Bt + (size_t)(n0 + R) * ldb + C;
    const size_t hA = (size_t)128 * lda, hB = (size_t)128 * ldb;
    char* l0 = smem + tid * 16;
    const int sw = (fr * 64 + fq * 16) ^ ((fr >> 3) << 5);
    const char* rdA = smem + (wr * 4) * 1024 + sw;
    const char* rdB = smem + 16384 + wc * 8192 + sw;
    const int nk = K / 32;
#define STAGE(stg, kt) do { char* _l = l0 + (stg) * 32768; int _k = (kt) + rot; _k = _k >= nk ? _k - nk : _k; _k *= 32; glds16(gA + _k, _l); glds16(gA + hA + _k, _l + 8192); glds16(gB + _k, _l + 16384); glds16(gB + hB + _k, _l + 24576); } while (0)
    __syncthreads();
    STAGE(0, 0); STAGE(1, 1); STAGE(2, 2); STAGE(3, 3);
    asm volatile("s_waitcnt vmcnt(12)" ::: "memory");
    __builtin_amdgcn_s_barrier();
    asm volatile("" ::: "memory");
    for (int kt = 0; kt < nk; ++kt) {
        const int stg = kt & 3;
        const char* pa = rdA + stg * 32768; const char* pb = rdB + stg * 32768;
        bf16x8 af[4], bfr[8];
#pragma unroll
        for (int mi = 0; mi < 4; ++mi) af[mi] = *(const bf16x8*)(pa + mi * 1024);
#pragma unroll
        for (int ni = 0; ni < 8; ++ni) bfr[ni] = *(const bf16x8*)(pb + ni * 1024);
        __builtin_amdgcn_sched_barrier(0);
        __builtin_amdgcn_s_setprio(1);
#pragma unroll
        for (int ni = 0; ni < 4; ++ni)
#pragma unroll
            for (int mi = 0; mi < 4; ++mi) acc[mi][ni] = __builtin_amdgcn_mfma_f32_16x16x32_bf16(bfr[ni], af[mi], acc[mi][ni], 0, 0, 0);
        __builtin_amdgcn_sched_barrier(0);
        if (kt + 3 < nk) asm volatile("s_waitcnt vmcnt(8)" ::: "memory");
        else if (kt + 2 < nk) asm volatile("s_waitcnt vmcnt(4)" ::: "memory");
        else asm volatile("s_waitcnt vmcnt(0)" ::: "memory");
        asm volatile("s_waitcnt lgkmcnt(0)" ::: "memory");
        __builtin_amdgcn_s_barrier();
        asm volatile("" ::: "memory");
        if (kt + 4 < nk) STAGE(stg, kt + 4);
        __builtin_amdgcn_sched_barrier(0);
#pragma unroll
        for (int ni = 4; ni < 8; ++ni)
#pragma unroll
            for (int mi = 0; mi < 4; ++mi) acc[mi][ni] = __builtin_amdgcn_mfma_f32_16x16x32_bf16(bfr[ni], af[mi], acc[mi][ni], 0, 0, 0);
        __builtin_amdgcn_s_setprio(0);
    }
#undef STAGE
}
DEV void zero_acc8(f32x4 (&acc)[4][8]) {
#pragma unroll
    for (int mi = 0; mi < 4; ++mi)
#pragma unroll
        for (int ni = 0; ni < 8; ++ni) acc[mi][ni] = (f32x4){0.f, 0.f, 0.f, 0.f};
}
template <int MI> DEV void zero_acc(f32x4 (&acc)[MI][4]) {
#pragma unroll
    for (int mi = 0; mi < MI; ++mi)
#pragma unroll
        for (int ni = 0; ni < 4; ++ni) acc[mi][ni] = (f32x4){0.f, 0.f, 0.f, 0.f};
}
DEV void store4(bf16_t* p, f32x4 v) { *(u32x2*)p = (u32x2){pk_bf16(v[0], v[1]), pk_bf16(v[2], v[3])}; }

#define WAVE_IDS const int tid = otid(), wid = tid >> 6, lane = tid & 63, wr = wid >> 1, wc = wid & 1, fr = lane & 15, fq = lane >> 4; (void)wid; (void)lane; (void)wr; (void)wc; (void)fr; (void)fq;

template <class Map>
DEV void cvt_transpose(const float* src, int ld, int K, int Ndst, bf16_t* dst, Map map, const float* kscale, char* smem) {
    float* t = (float*)smem;
    const int ntn = Ndst / 64, ntk = K / 64, tid = otid();
    for (int tile = obid(); tile < ntn * ntk; tile += onb()) {
        const int tn = tile % ntn, tk = tile / ntn;
        __syncthreads();
#pragma unroll
        for (int i = 0; i < 2; ++i) {
            const int e = tid + i * NTHR, kk = e >> 4, n4 = (e & 15) * 4; const int sc = map(tn * 64 + n4);
            f32x4 v = (f32x4){0.f, 0.f, 0.f, 0.f};
            if (sc >= 0) { v = *(const f32x4*)(src + (size_t)(tk * 64 + kk) * ld + sc); if (kscale) v *= kscale[tk * 64 + kk]; }
            t[(n4 + 0) * 65 + kk] = v[0]; t[(n4 + 1) * 65 + kk] = v[1]; t[(n4 + 2) * 65 + kk] = v[2]; t[(n4 + 3) * 65 + kk] = v[3];
        }
        __syncthreads();
        { const int nn = tid >> 3, k8 = (tid & 7) * 8; const float* r = t + nn * 65 + k8;
          *(u32x4*)(dst + (size_t)(tn * 64 + nn) * K + tk * 64 + k8) = (u32x4){pk_bf16(r[0], r[1]), pk_bf16(r[2], r[3]), pk_bf16(r[4], r[5]), pk_bf16(r[6], r[7])}; }
    }
}
DEV int map_h(int n) {
    if (n < 2816) return n;
    if (n < 3328) return n + 32;
    if (n < 4352) { const int j = n - 3328, tile = j >> 7, jj = j & 127, sub = jj >> 4, i = jj & 15; return 3360 + tile * 64 + (sub >> 1) * 16 + i + ((sub & 1) ? 512 : 0); }
    if (n < 5888) return n + 32;
    if (n < 5920) return 2816 + (n - 5888);
    return -1;
}
DEV void phase_prologue(const Params& p, char* smem) {
    char* ws = p.ws;
    for (int l = 0; l < 2; ++l) {
        cvt_transpose(p.w_in + (size_t)l * 1024 * IN_COLS, IN_COLS, 1024, NH, (bf16_t*)(ws + WOFF(WIN, l)), [](int n) { return map_h(n); }, nullptr, smem);
        cvt_transpose(p.w_in + (size_t)l * 1024 * IN_COLS, IN_COLS, 1024, 4096, (bf16_t*)(ws + WOFF(WM, l)), [](int n) { return 5920 + n; }, nullptr, smem);
        cvt_transpose(p.xattn_w + (size_t)l * 1024 * 1024, 1024, 1024, 1024, (bf16_t*)(ws + WOFF(WKVX, l)), [](int n) { return n; }, nullptr, smem);
        cvt_transpose(p.mla_w_uq + (size_t)l * 384 * 768, 768, 384, 768, (bf16_t*)(ws + WOFF(WUQ, l)), [](int n) { return n; }, p.mla_q_norm + l * 384, smem);
        cvt_transpose(p.mla_w_ukv + (size_t)l * 256 * 1024, 1024, 256, 512, (bf16_t*)(ws + WOFF(WUK, l)), [](int n) { return (n >> 6) * 128 + (n & 63); }, p.mla_kv_norm + l * 256, smem);
        cvt_transpose(p.mla_w_ukv + (size_t)l * 256 * 1024, 1024, 256, 512, (bf16_t*)(ws + WOFF(WUV, l)), [](int n) { return (n >> 6) * 128 + 64 + (n & 63); }, p.mla_kv_norm + l * 256, smem);
        for (int n = 0; n < 4; ++n)
            cvt_transpose(p.w_o_branch + ((size_t)l * 4 + n) * 512 * 1024, 1024, 512, 1024, (bf16_t*)(ws + WOFF(WO, l)) + (size_t)n * 1024 * 512, [](int c) { return c; }, nullptr, smem);
        cvt_transpose(p.w_out + (size_t)l * 1024 * 1024, 1024, 1024, 1024, (bf16_t*)(ws + WOFF(WOUT, l)), [](int n) { return n; }, nullptr, smem);
        cvt_transpose(p.rwkv_w2 + (size_t)l * 64 * 512, 512, 64, 512, (bf16_t*)(ws + WOFF(W2, l)), [](int n) { return n; }, nullptr, smem);
        cvt_transpose(p.rwkv_a2 + (size_t)l * 64 * 512, 512, 64, 512, (bf16_t*)(ws + WOFF(A2, l)), [](int n) { return n; }, nullptr, smem);
    }
    {
        const size_t n4 = (size_t)T_TOK * 1024 / 4; bf16_t* xb = (bf16_t*)p.out;
        for (size_t i = (size_t)obid() * NTHR + otid(); i < n4; i += (size_t)onb() * NTHR) { const f32x4 v = *(const f32x4*)(p.x + i * 4); store4(xb + i * 4, v); }
    }
    {
        const size_t n4 = (size_t)8192 * 1024 / 4; bf16_t* mb = (bf16_t*)(ws + OFF_MEMB);
        for (size_t i = (size_t)obid() * NTHR + otid(); i < n4; i += (size_t)onb() * NTHR) { const f32x4 v = *(const f32x4*)(p.mem + i * 4); store4(mb + i * 4, v); }
    }
    {
        float* cs = (float*)(ws + OFF_CS);
        for (size_t i = (size_t)obid() * NTHR + otid(); i < (size_t)T_TOK * 16; i += (size_t)onb() * NTHR) {
            const int t = (int)(i >> 4), j = (int)(i & 15);
            const float inv = (float)exp2(-(double)j * (13.287712379549449 / 16.0));
            const float ang = (float)p.pos[t] * inv;
            double rev = (double)ang * 0.15915494309189535; rev -= rint(rev);
            cs[(size_t)t * 32 + j] = __builtin_amdgcn_cosf((float)rev); cs[(size_t)t * 32 + 16 + j] = __builtin_amdgcn_sinf((float)rev);
        }
    }
}

DEV void bounce_put(char* reg, int mi, int ns, int fr, int fq, f32x4 v) { *(u32x2*)(reg + (mi * 16 + fr) * 272 + (ns * 16 + fq * 4) * 2) = (u32x2){pk_bf16(v[0], v[1]), pk_bf16(v[2], v[3])}; }
template <int NS> DEV void bounce_flush(const char* reg, bf16_t* dst, int ld, int lane) {
    constexpr int CH = NS * 2, RPP = 64 / CH;
    const int chunk = lane % CH, rsub = lane / CH;
    __builtin_amdgcn_sched_barrier(0);
#pragma unroll
    for (int ps = 0; ps < CH; ++ps) { const int row = ps * RPP + rsub; *(u32x4*)(dst + (size_t)row * ld + chunk * 8) = *(const u32x4*)(reg + row * 272 + chunk * 16);
        if ((ps & 3) == 3) __builtin_amdgcn_sched_barrier(0); }
}
DEV u32x2 pk4(f32x4 v) { return (u32x2){pk_bf16(v[0], v[1]), pk_bf16(v[2], v[3])}; }
DEV void epi_h(const Params& p, const f32x4 (&acc)[4][8], int m0, int n0g, int, int, int, int, char* smem) {
    const int tid_ = otid(), wid__ = tid_ >> 6, wr = wid__ >> 1, wc = wid__ & 1, fr = tid_ & 15, fq = (tid_ & 63) >> 4;
    char* ws = p.ws; const int n0 = n0g + wc * 128, ti = n0 >> 7;
    if (ti >= 47) return;
    bf16_t* dst = nullptr; int ld = 0, coff = 0, mode = 0;
    if (ti < 13) { dst = (bf16_t*)(ws + OFF_RWP); ld = 1664; coff = n0; }
    else if (ti < 17) { dst = (bf16_t*)(ws + OFF_Y); ld = 2048; coff = n0 - 1664; mode = 1; }
    else if (ti < 20) { dst = (bf16_t*)(ws + OFF_QL); ld = 384; coff = n0 - 2176; }
    else if (ti < 22) { dst = (bf16_t*)(ws + OFF_KVL); ld = 256; coff = n0 - 2560; }
    else if (ti < 26) { dst = (bf16_t*)(ws + OFF_Y); ld = 2048; coff = 512 + n0 - 2816; mode = 1; }
    else if (ti < 34) { dst = (bf16_t*)(ws + OFF_CU); ld = 512; coff = (ti - 26) * 64; mode = 2; }
    else if (ti < 38) { dst = (bf16_t*)(ws + OFF_Y); ld = 2048; coff = 1024 + n0 - 4352; mode = 1; }
    else if (ti < 42) { dst = (bf16_t*)(ws + OFF_XQ); ld = 512; coff = n0 - 4864; }
    else if (ti < 46) { dst = (bf16_t*)(ws + OFF_Y); ld = 2048; coff = 1536 + n0 - 5376; mode = 1; }
    else { dst = (bf16_t*)(ws + OFF_KPE); ld = 32; mode = 3; }
    const int mbase = m0 + wr * 64;
    const int lane_ = fq * 16 + fr; char* reg = smem + (wr * 2 + wc) * 17408;
    if (mode <= 1) {
#pragma unroll
        for (int mi = 0; mi < 4; ++mi)
#pragma unroll
            for (int ni = 0; ni < 8; ++ni) { f32x4 v = acc[mi][ni]; if (mode == 1) { v[0] = siluf_(v[0]); v[1] = siluf_(v[1]); v[2] = siluf_(v[2]); v[3] = siluf_(v[3]); } bounce_put(reg, mi, ni, fr, fq, v); }
        bounce_flush<8>(reg, dst + (size_t)mbase * ld + coff, ld, lane_);
    } else if (mode == 2) {
#pragma unroll
        for (int mi = 0; mi < 4; ++mi)
#pragma unroll
            for (int pp = 0; pp < 4; ++pp) { const f32x4 a = acc[mi][2 * pp], g = acc[mi][2 * pp + 1]; f32x4 v;
                v[0] = a[0] * sigmoidf_(g[0]); v[1] = a[1] * sigmoidf_(g[1]); v[2] = a[2] * sigmoidf_(g[2]); v[3] = a[3] * sigmoidf_(g[3]); bounce_put(reg, mi, pp, fr, fq, v); }
        bounce_flush<4>(reg, dst + (size_t)mbase * ld + coff, ld, lane_);
    } else {
        const float* cs = (const float*)(ws + OFF_CS);
#pragma unroll
        for (int mi = 0; mi < 4; ++mi) { const size_t row = mbase + mi * 16 + fr;
            const f32x4 c = *(const f32x4*)(cs + row * 32 + fq * 4), s = *(const f32x4*)(cs + row * 32 + 16 + fq * 4);
            const f32x4 x1 = acc[mi][0], x2 = acc[mi][1];
            store4(dst + row * 32 + fq * 4, x1 * c - x2 * s); store4(dst + row * 32 + 16 + fq * 4, x1 * s + x2 * c); }
    }
}
template <int MI> DEV void epi_plain(const f32x4 (&acc)[MI][4], bf16_t* dst, int ld, int m0, int n0, int, int, int, int) {
    const int tid_ = otid(), wid__ = tid_ >> 6, wr = wid__ >> 1, wc = wid__ & 1, fr = tid_ & 15, fq = (tid_ & 63) >> 4;
#pragma unroll
    for (int mi = 0; mi < MI; ++mi) { const size_t row = m0 + wr * 16 * MI + mi * 16 + fr;
#pragma unroll
        for (int ni = 0; ni < 4; ++ni) store4(dst + row * ld + n0 + wc * 64 + ni * 16 + fq * 4, acc[mi][ni]); }
}
DEV void epi_plain8(const f32x4 (&acc)[4][8], bf16_t* dst, int ld, int m0, int n0, int, int, int, int, char* smem) {
    const int tid_ = otid(), wid__ = tid_ >> 6, wr = wid__ >> 1, wc = wid__ & 1, fr = tid_ & 15, fq = (tid_ & 63) >> 4;
    char* reg = smem + (wr * 2 + wc) * 17408;
#pragma unroll
    for (int mi = 0; mi < 4; ++mi)
#pragma unroll
        for (int ni = 0; ni < 8; ++ni) bounce_put(reg, mi, ni, fr, fq, acc[mi][ni]);
    bounce_flush<8>(reg, dst + (size_t)(m0 + wr * 64) * ld + n0 + wc * 128, ld, fq * 16 + fr);
}
DEV void phase1(const Params& p, int l, char* smem) {
    WAVE_IDS
    char* ws = p.ws;
    const bf16_t* xb = l == 0 ? (const bf16_t*)p.out : (const bf16_t*)(ws + OFF_XB1);
    const bf16_t* win = (const bf16_t*)(ws + WOFF(WIN, l));
    const bf16_t* wkv = (const bf16_t*)(ws + WOFF(WKVX, l));
    const bf16_t* memb = (const bf16_t*)(ws + OFF_MEMB);
    const int nb = onb(), bid = obid();
    const int n_main = 256 * 24, n_items = n_main + 128;
    for (int it = bid; it < n_items; it += nb) {
        asm volatile("" ::: "memory");
        f32x4 acc[4][8]; zero_acc8(acc);
        if (it < n_main) {
            const int xcd = it & 7, w = it >> 3;
            const int g = w >> 5, within = w & 31, mtg = g / 6, ntg = g % 6;
            const int mt = xcd * 32 + mtg * 8 + (within >> 2), nt = ntg * 4 + (within & 3);
            gemm256(acc, xb, 1024, mt * 256, win, 1024, nt * 256, 1024, smem, ((within & 3) * 8 + (within >> 2)) & 31);
            epi_h(p, acc, mt * 256, nt * 256, wr, wc, fr, fq, smem);
        } else if (it < n_main + 64) {
            const int j = it - n_main, mt = j >> 1, nt = j & 1;
            gemm256(acc, memb, 1024, mt * 256, wkv, 1024, nt * 256, 1024, smem);
            epi_plain8(acc, (bf16_t*)(ws + OFF_XK), 512, mt * 256, nt * 256, wr, wc, fr, fq, smem);
        } else {
            const int j = it - n_main - 64, b = j >> 1, mt = j & 1;
            gemm256(acc, wkv + (size_t)512 * 1024, 1024, mt * 256, memb + (size_t)b * 256 * 1024, 1024, 0, 1024, smem);
            epi_plain8(acc, (bf16_t*)(ws + OFF_XVT) + (size_t)b * 512 * 256, 256, mt * 256, 0, wr, wc, fr, fq, smem);
        }
    }
}

template <int DQK, int DV, bool CAUSAL, int MIA>
DEV void attn_item(const bf16_t* Q, int ldq, const bf16_t* K1, int ldk1, int D1, const bf16_t* K2, int ldk2, const bf16_t* Vt, int ldvt,
                   int nkt, int q0, float scale_log2, bf16_t* Yp, int ldy, char* smem, int dry = 0) {
    constexpr int LDK = DQK + 16, LDV = 72, KCH = DQK / 8;
    constexpr int NKC = 64 * KCH / NTHR + ((64 * KCH) % NTHR ? 1 : 0), NVC = DV * 8 / NTHR;
    bf16_t* sK = (bf16_t*)smem;
    bf16_t* sV = sK + 64 * LDK;
    constexpr int STG = 64 * LDK + DV * LDV;
    const int tid = otid(), w = tid >> 6, lane = tid & 63, fr = lane & 15, fq = lane >> 4;
    bf16x8 qf[MIA][DQK / 32];
#pragma unroll
    for (int mi = 0; mi < MIA; ++mi)
#pragma unroll
        for (int ks = 0; ks < DQK / 32; ++ks) qf[mi][ks] = *(const bf16x8*)(Q + (size_t)(w * 16 * MIA + mi * 16 + fr) * ldq + ks * 32 + fq * 8);
    f32x4 o[MIA][DV / 16];
#pragma unroll
    for (int mi = 0; mi < MIA; ++mi)
#pragma unroll
        for (int di = 0; di < DV / 16; ++di) o[mi][di] = (f32x4){0.f, 0.f, 0.f, 0.f};
    float mrun[MIA], lrun[MIA];
#pragma unroll
    for (int mi = 0; mi < MIA; ++mi) { mrun[mi] = -1e30f; lrun[mi] = 0.f; }
    u32x4 kreg[NKC], vreg[NVC];
    auto gload = [&](int kt) {
#pragma unroll
        for (int i = 0; i < NKC; ++i) { const int c = tid + i * NTHR; if (c < 64 * KCH) { const int row = c / KCH, col = (c % KCH) * 8;
            kreg[i] = col < D1 ? *(const u32x4*)(K1 + (size_t)(kt * 64 + row) * ldk1 + col) : *(const u32x4*)(K2 + (size_t)(kt * 64 + row) * ldk2 + (col - D1)); } }
#pragma unroll
        for (int i = 0; i < NVC; ++i) { const int c = tid + i * NTHR, d = c >> 3, ch = c & 7; vreg[i] = *(const u32x4*)(Vt + (size_t)d * ldvt + kt * 64 + ch * 8); }
    };
    auto sstore = [&](int buf) {
#pragma unroll
        for (int i = 0; i < NKC; ++i) { const int c = tid + i * NTHR; if (c < 64 * KCH) { const int row = c / KCH, col = (c % KCH) * 8; *(u32x4*)(sK + buf * STG + row * LDK + col) = kreg[i]; } }
#pragma unroll
        for (int i = 0; i < NVC; ++i) { const int c = tid + i * NTHR, d = c >> 3, ch = c & 7; *(u32x4*)(sV + buf * STG + d * LDV + ch * 8) = vreg[i]; }
    };
    gload(0);
    __syncthreads();
    sstore(0);
    if (nkt > 1) gload(1);
    __syncthreads();
    int slot = 0;
    for (int kt = 0; kt < nkt; ++kt) {
        const int nslot = slot == 2 ? 0 : slot + 1;
        const bf16_t* cK = sK + slot * STG; const bf16_t* cV = sV + slot * STG;
        if (kt + 1 < nkt) { sstore(nslot); if (kt + 2 < nkt) gload(kt + 2); }
        const bool live = !(CAUSAL && kt * 64 > q0 + w * 16 * MIA + 16 * MIA - 1);
        f32x4 s[MIA][4];
        if (live) {
#pragma unroll
        for (int mi = 0; mi < MIA; ++mi)
#pragma unroll
            for (int ni = 0; ni < 4; ++ni) s[mi][ni] = (f32x4){0.f, 0.f, 0.f, 0.f};
#pragma unroll
        for (int ks = 0; ks < DQK / 32; ++ks)
#pragma unroll
            for (int ni = 0; ni < 4; ++ni) { const bf16x8 kf = *(const bf16x8*)(cK + (ni * 16 + fr) * LDK + ks * 32 + fq * 8);
#pragma unroll
                for (int mi = 0; mi < MIA; ++mi) s[mi][ni] = __builtin_amdgcn_mfma_f32_16x16x32_bf16(kf, qf[mi][ks], s[mi][ni], 0, 0, 0); }
        }
        __syncthreads();
        slot = nslot;
        if (live) {
        bf16x8 pf[MIA][2];
#pragma unroll
        for (int mi = 0; mi < MIA; ++mi) {
            float mx = -1e30f;
            if (CAUSAL && kt * 64 + 63 > q0 + w * 16 * MIA) {
                const int qabs = q0 + w * 16 * MIA + mi * 16 + fr;
#pragma unroll
                for (int ni = 0; ni < 4; ++ni)
#pragma unroll
                    for (int r = 0; r < 4; ++r) { const int kabs = kt * 64 + ni * 16 + fq * 4 + r; if (kabs > qabs) s[mi][ni][r] = -1e30f; }
            }
#pragma unroll
            for (int ni = 0; ni < 4; ++ni) mx = fmaxf(mx, fmaxf(fmaxf(s[mi][ni][0], s[mi][ni][1]), fmaxf(s[mi][ni][2], s[mi][ni][3])));
            mx = fmaxf(mx, __shfl_xor(mx, 16)); mx = fmaxf(mx, __shfl_xor(mx, 32));
            const float mnew = fmaxf(mrun[mi], mx);
            const float mc = mnew * scale_log2;
            float ps = 0.f;
#pragma unroll
            for (int ni = 0; ni < 4; ++ni)
#pragma unroll
                for (int r = 0; r < 4; ++r) { const float pv = __builtin_amdgcn_exp2f(__builtin_fmaf(s[mi][ni][r], scale_log2, -mc)); s[mi][ni][r] = pv; ps += pv; }
            if (__builtin_amdgcn_ballot_w64(mnew > mrun[mi]) != 0ull) {
                const float alpha = __builtin_amdgcn_exp2f((mrun[mi] - mnew) * scale_log2);
                lrun[mi] *= alpha;
#pragma unroll
                for (int di = 0; di < DV / 16; ++di) o[mi][di] *= alpha;
            }
            mrun[mi] = mnew;
            lrun[mi] += ps;
#pragma unroll
            for (int s2 = 0; s2 < 2; ++s2) { const f32x4 a = s[mi][2 * s2], b = s[mi][2 * s2 + 1];
                const u32x4 pk = (u32x4){pk_bf16(a[0], a[1]), pk_bf16(a[2], a[3]), pk_bf16(b[0], b[1]), pk_bf16(b[2], b[3])};
                pf[mi][s2] = __builtin_bit_cast(bf16x8, pk); }
        }
#pragma unroll
        for (int di = 0; di < DV / 16; ++di)
#pragma unroll
            for (int s2 = 0; s2 < 2; ++s2) {
                const u32x2 v0 = *(const u32x2*)(cV + (di * 16 + fr) * LDV + s2 * 32 + fq * 4), v1 = *(const u32x2*)(cV + (di * 16 + fr) * LDV + s2 * 32 + 16 + fq * 4);
                const bf16x8 vf = __builtin_bit_cast(bf16x8, ((u32x4){v0[0], v0[1], v1[0], v1[1]}));
#pragma unroll
                for (int mi = 0; mi < MIA; ++mi) o[mi][di] = __builtin_amdgcn_mfma_f32_16x16x32_bf16(vf, pf[mi][s2], o[mi][di], 0, 0, 0);
            }
        }
    }
#pragma unroll
    for (int mi = 0; mi < MIA; ++mi) {
        float lt = lrun[mi]; lt += __shfl_xor(lt, 16); lt += __shfl_xor(lt, 32);
        const float inv = __builtin_amdgcn_rcpf(lt);
        bf16_t* yrow = Yp + (size_t)(w * 16 * MIA + mi * 16 + fr) * ldy;
#pragma unroll
        for (int di = 0; di < DV / 16; ++di) { bf16_t* yp = yrow + di * 16 + fq * 4; const u32x2 g = *(const u32x2*)yp;
            f32x4 v = o[mi][di] * inv; v[0] *= bflo(g[0]); v[1] *= bfhi(g[0]); v[2] *= bflo(g[1]); v[3] *= bfhi(g[1]); if (!dry) store4(yp, v); }
    }
}

DEV void lora_item(const Params& p, int l, int mt, int which, char* smem) {
    WAVE_IDS
    char* ws = p.ws;
    bf16_t* sA = (bf16_t*)smem; bf16_t* sB = sA + 256 * LDSK;
    const bf16_t* rwp = (const bf16_t*)(ws + OFF_RWP);
    const bf16_t* wt = (const bf16_t*)(ws + (which ? WOFF(A2, l) : WOFF(W2, l)));
    const int colb = 1536 + which * 64;
    const float* mu = p.rwkv_mu + l * 1664 + colb;
    const float* bias = (which ? p.rwkv_a0 : p.rwkv_w0) + l * 512;
    bf16_t* ea = (bf16_t*)(ws + OFF_EA) + which * 512;
    __syncthreads();
    const int crow = tid >> 3, cch = tid & 7;
    u32x4 breg[8];
#pragma unroll
    for (int i = 0; i < 8; ++i) breg[i] = *(const u32x4*)(wt + (size_t)(crow + i * 64) * 64 + cch * 8);
#pragma unroll
    for (int i = 0; i < 4; ++i) {
        const int row = crow + i * 64; const size_t t = (size_t)mt * 256 + row;
        const u32x4 cur = *(const u32x4*)(rwp + t * 1664 + colb + cch * 8);
        u32x4 prv = (u32x4){0u, 0u, 0u, 0u};
        if ((t & (SEQ - 1)) != 0) prv = *(const u32x4*)(rwp + (t - 1) * 1664 + colb + cch * 8);
        float v[8];
#pragma unroll
        for (int j = 0; j < 4; ++j) { const float c0 = bflo(cur[j]), c1 = bfhi(cur[j]), p0 = bflo(prv[j]), p1 = bfhi(prv[j]);
            v[2 * j] = c0 + mu[cch * 8 + 2 * j] * (p0 - c0); v[2 * j + 1] = c1 + mu[cch * 8 + 2 * j + 1] * (p1 - c1); }
        if (which == 0) {
#pragma unroll
            for (int j = 0; j < 8; ++j) { const float e2 = __expf(2.0f * v[j]); v[j] = 1.0f - 2.0f * __builtin_amdgcn_rcpf(e2 + 1.0f); }
        }
        *(u32x4*)(sA + row * LDSK + cch * 8) = (u32x4){pk_bf16(v[0], v[1]), pk_bf16(v[2], v[3]), pk_bf16(v[4], v[5]), pk_bf16(v[6], v[7])};
    }
#pragma unroll
    for (int i = 0; i < 8; ++i) *(u32x4*)(sB + (crow + i * 64) * LDSK + cch * 8) = breg[i];
    __syncthreads();
    for (int nt = 0; nt < 4; ++nt) {
        f32x4 acc[4][4]; zero_acc<4>(acc);
        mma_ktile<4>(acc, sA, sB + nt * 128 * LDSK, wr, wc, fr, fq);
#pragma unroll
        for (int mi = 0; mi < 4; ++mi) { const size_t row = (size_t)mt * 256 + wr * 64 + mi * 16 + fr;
#pragma unroll
            for (int ni = 0; ni < 4; ++ni) { const int col = nt * 128 + wc * 64 + ni * 16 + fq * 4; const f32x4 bz = *(const f32x4*)(bias + col); f32x4 v = acc[mi][ni] + bz;
#pragma unroll
                for (int r = 0; r < 4; ++r) { const float sg = sigmoidf_(v[r]); v[r] = which ? sg : 0.6065306597f * sg; }
                store4(ea + row * 1024 + col, v); } }
    }
}
DEV void conv_item(const Params& p, int l, int tile, char* smem, int dry) {
    char* ws = p.ws;
    bf16_t* sin_ = (bf16_t*)smem;
    float* sout = (float*)(smem + 62 * 1024);
    const bf16_t* cu = (const bf16_t*)(ws + OFF_CU);
    bf16_t* Y = (bf16_t*)(ws + OFF_Y);
    const int tid = otid(), wid = tid >> 6, lane = tid & 63;
    const int t0 = tile * 32, s0 = t0 & (SEQ - 1);
    __syncthreads();
    for (int c = tid; c < 62 * 64; c += NTHR) { const int row = c >> 6, ch = c & 63; const int srel = s0 - 30 + row;
        u32x4 v = (u32x4){0u, 0u, 0u, 0u};
        if (srel >= 0) v = *(const u32x4*)(cu + (size_t)(t0 - 30 + row) * 512 + ch * 8);
        *(u32x4*)(sin_ + row * 512 + ch * 8) = v; }
    float w[31];
#pragma unroll
    for (int j = 0; j < 31; ++j) w[j] = p.conv_w[((size_t)l * 31 + j) * 512 + tid];
    const float cb = p.conv_b[l * 512 + tid];
    __syncthreads();
    {
        float acc[32];
#pragma unroll
        for (int t = 0; t < 32; ++t) acc[t] = cb;
#pragma unroll
        for (int r = 0; r < 62; ++r) {
            const float xv = bf2f(sin_[r * 512 + tid]);
#pragma unroll
            for (int t = 0; t < 32; ++t) if (r - t >= 0 && r - t <= 30) acc[t] += w[r - t] * xv;
        }
#pragma unroll
        for (int t = 0; t < 32; ++t) sout[t * 512 + tid] = acc[t];
    }
    __syncthreads();
    const f32x4 g0 = *(const f32x4*)(p.conv_ln_g + l * 512 + lane * 8), g1 = *(const f32x4*)(p.conv_ln_g + l * 512 + lane * 8 + 4);
    const f32x4 b0 = *(const f32x4*)(p.conv_ln_b + l * 512 + lane * 8), b1 = *(const f32x4*)(p.conv_ln_b + l * 512 + lane * 8 + 4);
#pragma unroll 1
    for (int t = wid; t < 32; t += 8) {
        const f32x4 x0 = *(const f32x4*)(sout + t * 512 + lane * 8), x1 = *(const f32x4*)(sout + t * 512 + lane * 8 + 4);
        float sm = (x0[0] + x0[1]) + (x0[2] + x0[3]) + (x1[0] + x1[1]) + (x1[2] + x1[3]);
        const float mean = wave_sum(sm) * (1.0f / 512.0f);
        const f32x4 d0 = x0 - mean, d1 = x1 - mean;
        float sq = (d0[0] * d0[0] + d0[1] * d0[1]) + (d0[2] * d0[2] + d0[3] * d0[3]) + (d1[0] * d1[0] + d1[1] * d1[1]) + (d1[2] * d1[2] + d1[3] * d1[3]);
        const float rstd = rsqrtf(wave_sum(sq) * (1.0f / 512.0f) + 1e-5f);
        bf16_t* yp = Y + (size_t)(t0 + t) * 2048 + 1024 + lane * 8;
        const u32x4 g = *(const u32x4*)yp;
        f32x4 y0 = d0 * rstd * g0 + b0, y1 = d1 * rstd * g1 + b1;
        float o[8];
#pragma unroll
        for (int j = 0; j < 4; ++j) { o[j] = siluf_(y0[j]); o[4 + j] = siluf_(y1[j]); }
#pragma unroll
        for (int j = 0; j < 4; ++j) { o[2 * j] *= bflo(g[j]); o[2 * j + 1] *= bfhi(g[j]); }
        if (!dry) *(u32x4*)yp = (u32x4){pk_bf16(o[0], o[1]), pk_bf16(o[2], o[3]), pk_bf16(o[4], o[5]), pk_bf16(o[6], o[7])};
    }
}
DEV void phase2(const Params& p, int l, char* smem, int dry = 0, int parts = 15) {
    char* ws = p.ws;
    const int nb = onb(), bid = obid();
    if (parts & 1) for (int it = bid; it < 512; it += nb) { asm volatile("" ::: "memory"); lora_item(p, l, it >> 1, it & 1, smem); }
    if (parts & 2) for (int j = bid; j < 2048; j += nb) {
        asm volatile("" ::: "memory");
        const int qb = j & 15, h = (j >> 4) & 3, b = j >> 6;
        const size_t t0 = (size_t)b * SEQ + qb * 128;
        attn_item<128, 128, false, 1>((const bf16_t*)(ws + OFF_XQ) + t0 * 512 + h * 128, 512,
                                      (const bf16_t*)(ws + OFF_XK) + (size_t)b * 256 * 512 + h * 128, 512, 128, nullptr, 0,
                                      (const bf16_t*)(ws + OFF_XVT) + ((size_t)b * 512 + h * 128) * 256, 256,
                                      4, 0, 0.08838834764831845f * 1.4426950408889634f, (bf16_t*)(ws + OFF_Y) + t0 * 2048 + 1536 + h * 128, 2048, smem, dry);
    }
    if (parts & 4) for (int it = bid; it < 2048; it += nb) { asm volatile("" ::: "memory"); conv_item(p, l, it, smem, dry); }
    if (!(parts & 8)) return;
    const int wid = otid() >> 6, lane = otid() & 63, li = lane & 15, tg = lane >> 4;
    const bf16_t* ql = (const bf16_t*)(ws + OFF_QL); const bf16_t* kvl = (const bf16_t*)(ws + OFF_KVL);
    float* rq = (float*)(ws + OFF_RQ); float* rkv = (float*)(ws + OFF_RKV);
    auto sq8 = [](u32x4 u) { float s = 0.f;
#pragma unroll
        for (int j = 0; j < 4; ++j) { const float a = bflo(u[j]), b = bfhi(u[j]); s += a * a + b * b; } return s; };
#pragma unroll 2
    for (int t = (bid * 8 + wid) * 4 + tg; t < T_TOK; t += nb * 32) {
        const u32x4* qp = (const u32x4*)(ql + (size_t)t * 384); const u32x4* kp = (const u32x4*)(kvl + (size_t)t * 256);
        const u32x4 q0 = qp[li], q1 = qp[li + 16], q2 = qp[li + 32], k0 = kp[li], k1 = kp[li + 16];
        float s = sq8(q0) + sq8(q1) + sq8(q2), s2 = sq8(k0) + sq8(k1);
        s += DPPF(s, 0xB1); s += DPPF(s, 0x4E); s += DPPF(s, 0x141); s += DPPF(s, 0x140);
        s2 += DPPF(s2, 0xB1); s2 += DPPF(s2, 0x4E); s2 += DPPF(s2, 0x141); s2 += DPPF(s2, 0x140);
        if (li == 0) { rq[t] = rsqrtf(s * (1.0f / 384.0f) + 1e-6f); rkv[t] = rsqrtf(s2 * (1.0f / 256.0f) + 1e-6f); }
    }
}

DEV void phase3(const Params& p, int l, char* smem, int dry = 0) {
    char* ws = p.ws;
    float* op = (float*)smem;
    float* ybuf = op + 2 * 32 * 384;
    float* bon = ybuf + 2 * 32 * 64;
    const bf16_t* rwp = (const bf16_t*)(ws + OFF_RWP);
    const bf16_t* ea = (const bf16_t*)(ws + OFF_EA);
    bf16_t* Y = (bf16_t*)(ws + OFF_Y);
    const int tid = otid();
    for (int chain = obid(); chain < 256; chain += onb()) {
        asm volatile("" ::: "memory");
        const int b = chain >> 3, h = chain & 7;
        __syncthreads();
        if (__builtin_amdgcn_readfirstlane(tid) >= 256) {
            const int pt = tid - 256, tok = pt >> 3, g = pt & 7, c0 = h * 64 + g * 8;
            float mur[8], muk[8], muv[8], kk_[8], ka_[8], rk_[8], lg[8], lb[8];
#pragma unroll
            for (int j = 0; j < 8; ++j) {
                mur[j] = p.rwkv_mu[l * 1664 + c0 + j]; muk[j] = p.rwkv_mu[l * 1664 + 512 + c0 + j]; muv[j] = p.rwkv_mu[l * 1664 + 1024 + c0 + j];
                kk_[j] = p.rwkv_k_k[l * 512 + c0 + j]; ka_[j] = p.rwkv_k_a[l * 512 + c0 + j]; rk_[j] = p.rwkv_r_k[l * 512 + c0 + j];
                lg[j] = p.rwkv_lnx_g[l * 512 + c0 + j]; lb[j] = p.rwkv_lnx_b[l * 512 + c0 + j];
            }
            auto prep = [&](int ci) {
                const int buf = ci & 1, s = ci * 32 + tok; const size_t t = (size_t)b * SEQ + s;
                const bf16_t* row = rwp + t * 1664 + c0;
                const u32x4 rc = *(const u32x4*)row, kc = *(const u32x4*)(row + 512), vc = *(const u32x4*)(row + 1024);
                u32x4 rp = (u32x4){0u, 0u, 0u, 0u}, kp = rp, vp = rp;
                if (s > 0) { rp = *(const u32x4*)(row - 1664); kp = *(const u32x4*)(row - 1664 + 512); vp = *(const u32x4*)(row - 1664 + 1024); }
                const u32x4 ee = *(const u32x4*)(ea + t * 1024 + c0), aa = *(const u32x4*)(ea + t * 1024 + 512 + c0);
                float r[8], k[8], v[8], kk[8], e[8], a[8];
#pragma unroll
                for (int j = 0; j < 4; ++j) {
                    float c, q;
                    c = bflo(rc[j]); q = bflo(rp[j]); r[2 * j] = c + mur[2 * j] * (q - c); c = bfhi(rc[j]); q = bfhi(rp[j]); r[2 * j + 1] = c + mur[2 * j + 1] * (q - c);
                    c = bflo(kc[j]); q = bflo(kp[j]); k[2 * j] = c + muk[2 * j] * (q - c); c = bfhi(kc[j]); q = bfhi(kp[j]); k[2 * j + 1] = c + muk[2 * j + 1] * (q - c);
                    c = bflo(vc[j]); q = bflo(vp[j]); v[2 * j] = c + muv[2 * j] * (q - c); c = bfhi(vc[j]); q = bfhi(vp[j]); v[2 * j + 1] = c + muv[2 * j + 1] * (q - c);
                    e[2 * j] = bflo(ee[j]); e[2 * j + 1] = bfhi(ee[j]); a[2 * j] = bflo(aa[j]); a[2 * j + 1] = bfhi(aa[j]);
                }
                float ss = 0.f;
#pragma unroll
                for (int j = 0; j < 8; ++j) { kk[j] = k[j] * kk_[j]; ss += kk[j] * kk[j]; }
                ss += __shfl_xor(ss, 1); ss += __shfl_xor(ss, 2); ss += __shfl_xor(ss, 4);
                const float inv = 1.0f / fmaxf(sqrtf(ss), 1e-12f);
                float* o = op + (size_t)(buf * 32 + tok) * 384 + g * 8;
                float bs = 0.f;
#pragma unroll
                for (int j = 0; j < 8; ++j) {
                    const float kn = kk[j] * inv, km = k[j] * (1.0f + (a[j] - 1.0f) * ka_[j]);
                    o[j] = -kn; o[64 + j] = __expf(-e[j]); o[128 + j] = kn * a[j]; o[192 + j] = km; o[256 + j] = r[j]; o[320 + j] = v[j];
                    bs += r[j] * km * rk_[j];
                }
                bs += __shfl_xor(bs, 1); bs += __shfl_xor(bs, 2); bs += __shfl_xor(bs, 4);
                if (g == 0) bon[buf * 32 + tok] = bs;
            };
            auto post = [&](int ci) {
                const int buf = ci & 1, s = ci * 32 + tok; const size_t t = (size_t)b * SEQ + s;
                const float* yb = ybuf + (buf * 32 + tok) * 64 + g * 8;
                float y[8]; float sm = 0.f;
#pragma unroll
                for (int j = 0; j < 8; ++j) { y[j] = yb[j]; sm += y[j]; }
                sm += __shfl_xor(sm, 1); sm += __shfl_xor(sm, 2); sm += __shfl_xor(sm, 4);
                const float mean = sm * (1.0f / 64.0f); float sq = 0.f;
#pragma unroll
                for (int j = 0; j < 8; ++j) { y[j] -= mean; sq += y[j] * y[j]; }
                sq += __shfl_xor(sq, 1); sq += __shfl_xor(sq, 2); sq += __shfl_xor(sq, 4);
                const float rstd = rsqrtf(sq * (1.0f / 64.0f) + 64e-5f);
                const float bo = bon[buf * 32 + tok];
                const float* vv = op + (size_t)(buf * 32 + tok) * 384 + 320 + g * 8;
                bf16_t* yp = Y + t * 2048 + c0;
                const u32x4 gg = *(const u32x4*)yp;
                float o[8];
#pragma unroll
                for (int j = 0; j < 8; ++j) o[j] = y[j] * rstd * lg[j] + lb[j] + bo * vv[j];
#pragma unroll
                for (int j = 0; j < 4; ++j) { o[2 * j] *= bflo(gg[j]); o[2 * j + 1] *= bfhi(gg[j]); }
                if (!dry) *(u32x4*)yp = (u32x4){pk_bf16(o[0], o[1]), pk_bf16(o[2], o[3]), pk_bf16(o[4], o[5]), pk_bf16(o[6], o[7])};
            };
            prep(0);
            __syncthreads();
            for (int ci = 0; ci < 64; ++ci) {
                if (ci >= 1) post(ci - 1);
                if (ci + 1 < 64) prep(ci + 1);
                __syncthreads();
            }
            post(63);
        } else {
            const int vp = tid >> 3, kq = tid & 7;
            f32x2 st[2][4];
#pragma unroll
            for (int i = 0; i < 2; ++i)
#pragma unroll
                for (int j = 0; j < 4; ++j) st[i][j] = (f32x2){0.f, 0.f};
            __syncthreads();
            for (int ci = 0; ci < 64; ++ci) {
                const int buf = ci & 1;
                const float* base0 = op + (size_t)buf * 32 * 384 + kq * 8;
                float* yb = ybuf + buf * 32 * 64 + 2 * vp;
#pragma unroll 16
                for (int tok = 0; tok < 32; ++tok) {
                    const float* bs = base0 + tok * 384;
                    const f32x4 a0 = *(const f32x4*)bs, a1 = *(const f32x4*)(bs + 4);
                    const f32x4 w0 = *(const f32x4*)(bs + 64), w1 = *(const f32x4*)(bs + 68);
                    const f32x4 b0 = *(const f32x4*)(bs + 128), b1 = *(const f32x4*)(bs + 132);
                    const f32x4 k0 = *(const f32x4*)(bs + 192), k1 = *(const f32x4*)(bs + 196);
                    const f32x4 r0 = *(const f32x4*)(bs + 256), r1 = *(const f32x4*)(bs + 260);
                    const f32x2 vv = *(const f32x2*)(op + (size_t)(buf * 32 + tok) * 384 + 320 + 2 * vp);
                    const f32x2 av[4] = {(f32x2){a0[0], a0[1]}, (f32x2){a0[2], a0[3]}, (f32x2){a1[0], a1[1]}, (f32x2){a1[2], a1[3]}};
                    const f32x2 wv[4] = {(f32x2){w0[0], w0[1]}, (f32x2){w0[2], w0[3]}, (f32x2){w1[0], w1[1]}, (f32x2){w1[2], w1[3]}};
                    const f32x2 bv[4] = {(f32x2){b0[0], b0[1]}, (f32x2){b0[2], b0[3]}, (f32x2){b1[0], b1[1]}, (f32x2){b1[2], b1[3]}};
                    const f32x2 kv[4] = {(f32x2){k0[0], k0[1]}, (f32x2){k0[2], k0[3]}, (f32x2){k1[0], k1[1]}, (f32x2){k1[2], k1[3]}};
                    const f32x2 rv[4] = {(f32x2){r0[0], r0[1]}, (f32x2){r0[2], r0[3]}, (f32x2){r1[0], r1[1]}, (f32x2){r1[2], r1[3]}};
                    float yo[2];
#pragma unroll
                    for (int i = 0; i < 2; ++i) {
                        f32x2 sa2 = st[i][0] * av[0]; sa2 += st[i][1] * av[1]; sa2 += st[i][2] * av[2]; sa2 += st[i][3] * av[3];
                        const float sa = reduce8_dpp(sa2[0] + sa2[1]);
                        const float vi = vv[i];
                        f32x2 y2 = (f32x2){0.f, 0.f};
#pragma unroll
                        for (int j = 0; j < 4; ++j) { st[i][j] = st[i][j] * wv[j] + sa * bv[j] + vi * kv[j]; y2 += st[i][j] * rv[j]; }
                        yo[i] = reduce8_dpp(y2[0] + y2[1]);
                    }
                    if (kq == 0) *(f32x2*)(yb + tok * 64) = (f32x2){yo[0], yo[1]};
                }
                __syncthreads();
            }
        }
    }
}

DEV void phase4(const Params& p, int l, char* smem) {
    WAVE_IDS
    char* ws = p.ws;
    const bf16_t* ql = (const bf16_t*)(ws + OFF_QL); const bf16_t* kvl = (const bf16_t*)(ws + OFF_KVL);
    const float* rq = (const float*)(ws + OFF_RQ); const float* rkv = (const float*)(ws + OFF_RKV);
    const float* cs = (const float*)(ws + OFF_CS);
    bf16_t* qb = (bf16_t*)(ws + OFF_QB); bf16_t* kn = (bf16_t*)(ws + OFF_KN); bf16_t* vtm = (bf16_t*)(ws + OFF_VTM);
    const bf16_t* wuq = (const bf16_t*)(ws + WOFF(WUQ, l)); const bf16_t* wuk = (const bf16_t*)(ws + WOFF(WUK, l)); const bf16_t* wuv = (const bf16_t*)(ws + WOFF(WUV, l));
    const int n_items = 768 + 512 + 512;
    for (int it = obid(); it < n_items; it += onb()) {
        asm volatile("" ::: "memory");
        f32x4 acc[4][8]; zero_acc8(acc);
        if (it < 768) {
            const int mt = it / 3, nt = it % 3, m0 = mt * 256, n0 = nt * 256 + wc * 128;
            gemm256(acc, ql, 384, m0, wuq, 384, nt * 256, 384, smem);
#pragma unroll
            for (int mi = 0; mi < 4; ++mi) { const size_t row = m0 + wr * 64 + mi * 16 + fr; const float rs = rq[row];
                const f32x4 c = *(const f32x4*)(cs + row * 32 + fq * 4), s = *(const f32x4*)(cs + row * 32 + 16 + fq * 4);
#pragma unroll
                for (int ni = 0; ni < 8; ++ni) acc[mi][ni] *= rs;
#pragma unroll
                for (int pp = 0; pp < 4; ++pp) { const int cs0 = n0 + pp * 32; if ((cs0 % 96) == 64) { const f32x4 x1 = acc[mi][2 * pp], x2 = acc[mi][2 * pp + 1]; acc[mi][2 * pp] = x1 * c - x2 * s; acc[mi][2 * pp + 1] = x1 * s + x2 * c; } }
#pragma unroll
                for (int ni = 0; ni < 8; ++ni) store4(qb + row * 768 + n0 + ni * 16 + fq * 4, acc[mi][ni]); }
        } else if (it < 1280) {
            const int j = it - 768, mt = j >> 1, nt = j & 1, m0 = mt * 256, n0 = nt * 256 + wc * 128;
            gemm256(acc, kvl, 256, m0, wuk, 256, nt * 256, 256, smem);
#pragma unroll
            for (int mi = 0; mi < 4; ++mi) { const size_t row = m0 + wr * 64 + mi * 16 + fr; const float rs = rkv[row];
#pragma unroll
                for (int ni = 0; ni < 8; ++ni) store4(kn + row * 512 + n0 + ni * 16 + fq * 4, acc[mi][ni] * rs); }
        } else {
            const int j = it - 1280, b = j >> 4, mt = (j >> 3) & 1, nt = j & 7, m0 = mt * 256, n0 = nt * 256 + wc * 128;
            gemm256(acc, wuv, 256, m0, kvl + (size_t)b * SEQ * 256, 256, nt * 256, 256, smem);
#pragma unroll
            for (int ni = 0; ni < 8; ++ni) { const int col = n0 + ni * 16 + fq * 4; const f32x4 rs = *(const f32x4*)(rkv + (size_t)b * SEQ + col);
#pragma unroll
                for (int mi = 0; mi < 4; ++mi) { const size_t row = m0 + wr * 64 + mi * 16 + fr; store4(vtm + ((size_t)b * 512 + row) * SEQ + col, acc[mi][ni] * rs); } }
        }
    }
}

DEV void phase5(const Params& p, char* smem, int dry = 0) {
    char* ws = p.ws;
    for (int it = obid(); it < 2048; it += onb()) {
        asm volatile("" ::: "memory");
        const int bh = it & 255, qb = 7 - (it >> 8), b = bh >> 3, h = bh & 7;
        const size_t t0 = (size_t)b * SEQ + qb * 256;
        __syncthreads();
        attn_item<96, 64, true, 2>((const bf16_t*)(ws + OFF_QB) + t0 * 768 + h * 96, 768,
                                (const bf16_t*)(ws + OFF_KN) + (size_t)b * SEQ * 512 + h * 64, 512, 64,
                                (const bf16_t*)(ws + OFF_KPE) + (size_t)b * SEQ * 32, 32,
                                (const bf16_t*)(ws + OFF_VTM) + ((size_t)b * 512 + h * 64) * SEQ, SEQ,
                                (qb + 1) * 4, qb * 256, 0.10206207261596577f * 1.4426950408889634f, (bf16_t*)(ws + OFF_Y) + t0 * 2048 + 512 + h * 64, 2048, smem, dry);
    }
}

DEV void phase6(const Params& p, int l, char* smem) {
    WAVE_IDS
    char* ws = p.ws;
    const bf16_t* xb = l == 0 ? (const bf16_t*)p.out : (const bf16_t*)(ws + OFF_XB1);
    const bf16_t* wm = (const bf16_t*)(ws + WOFF(WM, l)); const bf16_t* wo = (const bf16_t*)(ws + WOFF(WO, l));
    const bf16_t* Y = (const bf16_t*)(ws + OFF_Y); bf16_t* mg = (bf16_t*)(ws + OFF_MG);
    bool first_gemm = true;
    for (int it = obid(); it < 256 * 8; it += onb()) {
        asm volatile("" ::: "memory");
        const int xcd = it & 7, w = it >> 3, mt = xcd * 32 + (w >> 5) * 4 + ((w & 31) >> 3), nt = w & 7, m0 = mt * 256, n0 = nt * 128;
        f32x4 mrg[4][4]; zero_acc<4>(mrg);
        for (int n = 0; n < 4; ++n) {
            u32x2 gpk[4][4];
            {
                f32x4 ag[4][4]; zero_acc<4>(ag);
                if (first_gemm) { gemm_mainloop<4, 1, 1>(ag, xb, 1024, m0, wm + (size_t)n * 1024 * 1024, 1024, n0, 1024, smem, ((w & 7) * 2 + ((w >> 3) & 1)) & 15); first_gemm = false; }
                else gemm_mainloop<4, 1, 0>(ag, xb, 1024, m0, wm + (size_t)n * 1024 * 1024, 1024, n0, 1024, smem, ((w & 7) * 2 + ((w >> 3) & 1)) & 15);
#pragma unroll
                for (int ni = 0; ni < 4; ++ni) { const f32x4 bz = *(const f32x4*)(p.b_gate + ((size_t)l * 4 + n) * 1024 + n0 + wc * 64 + ni * 16 + fq * 4);
#pragma unroll
                    for (int mi = 0; mi < 4; ++mi) { const f32x4 v = ag[mi][ni] + bz; gpk[mi][ni] = (u32x2){pk_bf16(sigmoidf_(v[0]), sigmoidf_(v[1])), pk_bf16(sigmoidf_(v[2]), sigmoidf_(v[3]))}; } }
            }
            f32x4 ap[4][4]; zero_acc<4>(ap);
            gemm_mainloop<4, 0, 0>(ap, Y + n * 512, 2048, m0, wo + (size_t)n * 1024 * 512, 512, n0, 512, smem, w & 7);
#pragma unroll
            for (int mi = 0; mi < 4; ++mi)
#pragma unroll
                for (int ni = 0; ni < 4; ++ni) { const u32x2 g = gpk[mi][ni]; mrg[mi][ni] += (f32x4){bflo(g[0]), bfhi(g[0]), bflo(g[1]), bfhi(g[1])} * ap[mi][ni]; }
        }
        epi_plain<4>(mrg, mg, 1024, m0, n0, wr, wc, fr, fq);
    }
}
DEV void phase7(const Params& p, int l, char* smem) {
    WAVE_IDS
    char* ws = p.ws;
    const bf16_t* mg = (const bf16_t*)(ws + OFF_MG); const bf16_t* wout = (const bf16_t*)(ws + WOFF(WOUT, l)); bf16_t* o = (bf16_t*)(ws + OFF_OUT);
    for (int it = obid(); it < 256 * 4; it += onb()) {
        asm volatile("" ::: "memory");
        const int xcd = it & 7, w = it >> 3, mt = xcd * 32 + (w >> 2), nt = w & 3;
        f32x4 acc[4][8]; zero_acc8(acc);
        gemm256(acc, mg, 1024, mt * 256, wout, 1024, nt * 256, 1024, smem, ((w & 3) * 8 + ((w >> 2) & 7)) & 31);
        epi_plain8(acc, o, 1024, mt * 256, nt * 256, wr, wc, fr, fq, smem);
    }
}
DEV void phase8(const Params& p, int l) {
    char* ws = p.ws;
    const float* xin = l == 0 ? p.x : p.out; const bf16_t* o = (const bf16_t*)(ws + OFF_OUT);
    const int wid = otid() >> 6, lane = otid() & 63;
    const float alpha = 1.4142135623730951f;
    for (int t = obid() * 8 + wid; t < T_TOK; t += onb() * 8) {
        f32x4 v[4]; float sm = 0.f;
#pragma unroll
        for (int j = 0; j < 4; ++j) { const int col = j * 256 + lane * 4; const f32x4 xv = *(const f32x4*)(xin + (size_t)t * 1024 + col); const u32x2 ov = *(const u32x2*)(o + (size_t)t * 1024 + col);
            v[j] = xv * alpha + (f32x4){bflo(ov[0]), bfhi(ov[0]), bflo(ov[1]), bfhi(ov[1])}; sm += (v[j][0] + v[j][1]) + (v[j][2] + v[j][3]); }
        const float mean = wave_sum(sm) * (1.0f / 1024.0f); float sq = 0.f;
#pragma unroll
        for (int j = 0; j < 4; ++j) { v[j] -= mean; sq += (v[j][0] * v[j][0] + v[j][1] * v[j][1]) + (v[j][2] * v[j][2] + v[j][3] * v[j][3]); }
        const float rstd = rsqrtf(wave_sum(sq) * (1.0f / 1024.0f) + 1e-5f);
#pragma unroll
        for (int j = 0; j < 4; ++j) { const int col = j * 256 + lane * 4; const f32x4 g = *(const f32x4*)(p.ln_g + l * 1024 + col), bb = *(const f32x4*)(p.ln_b + l * 1024 + col);
            const f32x4 ov = v[j] * rstd * g + bb;
            *(f32x4*)(p.out + (size_t)t * 1024 + col) = ov;
            if (l == 0) store4((bf16_t*)(ws + OFF_XB1) + (size_t)t * 1024 + col, ov); }
    }
}

#ifndef REP_PH
#define REP_PH 0
#endif
#ifndef PHMASK
#define PHMASK 0x1ff
#endif

#define XB_TMO      128
#define XB_XCNT(j)  (256  + 64 * (j))
#define XB_XSUB(j)  (1280 + 64 * (j))
#define XB_XGEN(j)  (2304 + 64 * (j))
#define XB_TOP      3328
#define XB_TOPGEN   3392
#define XCD_BAR_WORDS 3456
#define XB_SPIN_CAP (1u << 18)
#define LAS __attribute__((address_space(3)))
DEV unsigned xb_ld(unsigned* p)              { return __hip_atomic_load(p, __ATOMIC_RELAXED, __HIP_MEMORY_SCOPE_AGENT); }
DEV unsigned xb_add(unsigned* p, unsigned v) { return __hip_atomic_fetch_add(p, v, __ATOMIC_RELAXED, __HIP_MEMORY_SCOPE_AGENT); }
DEV unsigned xb_xcc_id() { return (unsigned)__builtin_amdgcn_s_getreg((3 << 11) | 20) & 0xFu; }
#define XB_SPIN(cond, bar) do { unsigned _sp = 0; while (cond) { __builtin_amdgcn_s_sleep(1); \
    if ((++_sp & 255u) == 0u) { if (xb_ld(&(bar)[XB_TMO])) break; if (_sp > XB_SPIN_CAP) { atomicAdd(&(bar)[XB_TMO], 1u); break; } } } } while (0)
struct XcdBarrier { unsigned* bar; unsigned x; volatile LAS unsigned* st; };
DEV XcdBarrier xcd_barrier_post(unsigned* bar, volatile LAS unsigned* st) {
    XcdBarrier b; b.bar = bar; b.x = xb_xcc_id(); b.st = st;
    if (threadIdx.x == 0) st[3] = xb_add(&bar[XB_XCNT(b.x)], 1u);
    return b;
}
DEV void xcd_barrier_complete(unsigned* bar, unsigned x, unsigned& nloc, unsigned& nx) {
    const unsigned G = gridDim.x * gridDim.y * gridDim.z;
    unsigned sum, cnt, mine, sp = 0u;
    for (;;) {
        sum = 0u; cnt = 0u; mine = 0u;
#pragma unroll
        for (unsigned j = 0; j < 16; ++j) { const unsigned c = xb_ld(&bar[XB_XCNT(j)]); sum += c; cnt += (c > 0u) ? 1u : 0u; mine = (j == x) ? c : mine; }
        if (sum == G) break;
        __builtin_amdgcn_s_sleep(1);
        if ((++sp & 255u) == 0u) { if (xb_ld(&bar[XB_TMO])) break; if (sp > XB_SPIN_CAP) { atomicAdd(&bar[XB_TMO], 1u); break; } }
    }
    nloc = mine > 0u ? mine : 1u; nx = cnt > 0u ? cnt : 1u;
}
DEV void xcd_barrier(const XcdBarrier& b) {
    asm volatile("s_waitcnt vmcnt(0)" ::: "memory");
    __syncthreads();
    if (threadIdx.x == 0) {
        unsigned* bar = b.bar;
        __builtin_amdgcn_s_waitcnt(0);
        unsigned nloc = b.st[0], nx = b.st[1];
        if (nloc == 0u) { xcd_barrier_complete(bar, b.x, nloc, nx); b.st[0] = nloc; b.st[1] = nx; }
        const unsigned old = xb_add(&bar[XB_XSUB(b.x)], 1u);
        const unsigned gen = old / nloc;
        if (old + 1u == (gen + 1u) * nloc) {
            __builtin_amdgcn_fence(__ATOMIC_RELEASE, "agent");
            asm volatile("s_waitcnt vmcnt(0)" ::: "memory");
            const unsigned og = xb_add(&bar[XB_TOP], 1u);
            const unsigned tg = og / nx;
            if (og + 1u == (tg + 1u) * nx) xb_add(&bar[XB_TOPGEN], 1u);
            else XB_SPIN(xb_ld(&bar[XB_TOPGEN]) == tg, bar);
            __builtin_amdgcn_fence(__ATOMIC_ACQUIRE, "agent");
            xb_add(&bar[XB_XGEN(b.x)], 1u);
            asm volatile("s_waitcnt vmcnt(0)" ::: "memory");
        } else {
            XB_SPIN(xb_ld(&bar[XB_XGEN(b.x)]) == gen, bar);
            __builtin_amdgcn_fence(__ATOMIC_ACQUIRE, "agent");
            asm volatile("s_waitcnt vmcnt(0)" ::: "memory");
        }
    }
    __syncthreads();
}
constexpr size_t OFF_BAR = ((WS_END + 4095) / 4096) * 4096;
#define GSYNC_CG() do { asm volatile("s_waitcnt vmcnt(0) lgkmcnt(0)" ::: "memory"); grid.sync(); } while (0)
#define GSYNC() xcd_barrier(xb)
typedef const __attribute__((address_space(4))) Params* KParams;
DEV Params load_params() {
#if defined(__HIP_DEVICE_COMPILE__)
    auto k = __builtin_amdgcn_kernarg_segment_ptr();
    asm volatile("" : "+s"(k) :: "memory");
    return *(KParams)k;
#else
    return Params{};
#endif
}
__global__ void __launch_bounds__(NTHR) mega_fwd(Params p_unused) {
    char* smem = smem_g;
    cg::grid_group grid = cg::this_grid();
    XcdBarrier xb;
    {
        volatile LAS unsigned* st = (volatile LAS unsigned*)(smem + LDS_MAIN);
        if (threadIdx.x == 0) { st[0] = 0u; st[1] = 0u; st[2] = blockIdx.x; st[3] = 0u; }
        __syncthreads();
        const Params p = load_params();
        xb = xcd_barrier_post((unsigned*)(p.ws + OFF_BAR), st);
    }
    if (PHMASK & 1) { const Params p = load_params(); phase_prologue(p, smem); }
    GSYNC_CG();
    {
        if (threadIdx.x == 0) {
            const unsigned G = gridDim.x; bool ok = (G % 8u) == 0u;
            for (unsigned j = 0; j < 16; ++j) { const unsigned c = xb_ld(&xb.bar[XB_XCNT(j)]); ok = ok && (c == (j < 8u ? G / 8u : 0u)); }
            if (ok) xb.st[2] = xb.st[3] * 8u + xb.x;
        }
        __syncthreads();
    }
    if (REP_PH == 9) { const Params p = load_params(); phase_prologue(p, smem); GSYNC(); }
    if (REP_PH == 10) { for (int q = 0; q < 20; ++q) GSYNC(); }
    for (int l = 0; l < 2; ++l) {
        if (PHMASK & 2) { const Params p = load_params(); phase1(p, l, smem); } GSYNC();
        if (REP_PH == 1) { const Params p = load_params(); int dry = 1; asm volatile("" : "+s"(dry)); phase1(p, l, smem); GSYNC(); }
        if (PHMASK & 4) { const Params p = load_params(); phase2(p, l, smem); } GSYNC();
        if (REP_PH == 2) { const Params p = load_params(); int dry = 1; asm volatile("" : "+s"(dry)); phase2(p, l, smem, dry); GSYNC(); }
        if (REP_PH >= 31 && REP_PH <= 34) { const Params p = load_params(); int dry = 1, parts = 1 << (REP_PH - 31); asm volatile("" : "+s"(dry), "+s"(parts)); phase2(p, l, smem, dry, parts); GSYNC(); }
        if (PHMASK & 8) { const Params p = load_params(); phase3(p, l, smem); } GSYNC();
        if (REP_PH == 3) { const Params p = load_params(); int dry = 1; asm volatile("" : "+s"(dry)); phase3(p, l, smem, dry); GSYNC(); }
        if (PHMASK & 16) { const Params p = load_params(); phase4(p, l, smem); } GSYNC();
        if (REP_PH == 4) { const Params p = load_params(); int dry = 1; asm volatile("" : "+s"(dry)); phase4(p, l, smem); GSYNC(); }
        if (PHMASK & 32) { const Params p = load_params(); phase5(p, smem); } GSYNC();
        if (REP_PH == 5) { const Params p = load_params(); int dry = 1; asm volatile("" : "+s"(dry)); phase5(p, smem, dry); GSYNC(); }
        if (PHMASK & 64) { const Params p = load_params(); phase6(p, l, smem); } GSYNC();
        if (REP_PH == 6) { const Params p = load_params(); int dry = 1; asm volatile("" : "+s"(dry)); phase6(p, l, smem); GSYNC(); }
        if (PHMASK & 128) { const Params p = load_params(); phase7(p, l, smem); } GSYNC();
        if (REP_PH == 7) { const Params p = load_params(); int dry = 1; asm volatile("" : "+s"(dry)); phase7(p, l, smem); GSYNC(); }
        if (PHMASK & 256) { const Params p = load_params(); phase8(p, l); }
        if (l == 0) GSYNC();
    }
}

extern "C" void kernel_launch(void* const* d_in, const int* in_sizes, int n_in, void* d_out, int out_size, void* d_ws, size_t ws_size, hipStream_t stream) {
    static int grid_blocks = 0;
    if (grid_blocks == 0) {
        if (n_in != 28 || ws_size < OFF_BAR + XCD_BAR_WORDS * 4) { fprintf(stderr, "kernel_launch: unexpected n_in %d or ws %zu (< %zu)\n", n_in, ws_size, (size_t)WS_END); grid_blocks = -1; return; }
        int dev = 0, cus = 0, per_cu = 0;
        hipGetDevice(&dev);
        hipDeviceGetAttribute(&cus, hipDeviceAttributeMultiprocessorCount, dev);
        if (hipFuncSetAttribute((const void*)mega_fwd, hipFuncAttributeMaxDynamicSharedMemorySize, LDS_BYTES) != hipSuccess) { fprintf(stderr, "hipFuncSetAttribute failed\n"); grid_blocks = -1; return; }
        hipOccupancyMaxActiveBlocksPerMultiprocessor(&per_cu, (const void*)mega_fwd, NTHR, LDS_BYTES);
        if (per_cu < 1) { fprintf(stderr, "occupancy query returned %d\n", per_cu); grid_blocks = -1; return; }
        grid_blocks = cus * 1;
    }
    if (grid_blocks < 0) return;
    Params p{};
    p.x = (const float*)d_in[0]; p.mem = (const float*)d_in[1]; p.pos = (const int*)d_in[2]; p.w_in = (const float*)d_in[3]; p.b_gate = (const float*)d_in[4];
    p.rwkv_mu = (const float*)d_in[5]; p.rwkv_w0 = (const float*)d_in[6]; p.rwkv_w2 = (const float*)d_in[7]; p.rwkv_a0 = (const float*)d_in[8]; p.rwkv_a2 = (const float*)d_in[9];
    p.rwkv_k_k = (const float*)d_in[10]; p.rwkv_k_a = (const float*)d_in[11]; p.rwkv_r_k = (const float*)d_in[12]; p.rwkv_lnx_g = (const float*)d_in[13]; p.rwkv_lnx_b = (const float*)d_in[14];
    p.mla_q_norm = (const float*)d_in[15]; p.mla_w_uq = (const float*)d_in[16]; p.mla_kv_norm = (const float*)d_in[17]; p.mla_w_ukv = (const float*)d_in[18];
    p.conv_w = (const float*)d_in[19]; p.conv_b = (const float*)d_in[20]; p.conv_ln_g = (const float*)d_in[21]; p.conv_ln_b = (const float*)d_in[22];
    p.xattn_w = (const float*)d_in[23]; p.w_o_branch = (const float*)d_in[24]; p.w_out = (const float*)d_in[25]; p.ln_g = (const float*)d_in[26]; p.ln_b = (const float*)d_in[27];
    p.out = (float*)d_out; p.ws = (char*)d_ws;
    if (hipMemsetAsync((char*)d_ws + OFF_BAR, 0, XCD_BAR_WORDS * 4, stream) != hipSuccess) { fprintf(stderr, "memset failed\n"); return; }
    void* args[] = {&p};
    hipError_t e = hipLaunchCooperativeKernel((const void*)mega_fwd, dim3(grid_blocks), dim3(NTHR), args, LDS_BYTES, stream);
    if (e != hipSuccess) fprintf(stderr, "cooperative launch failed: %s (grid %d)\n", hipGetErrorString(e), grid_blocks);
}
```
